# Optimizing an MI355X kernel written in HIP

```python
import math
import jax, jax.numpy as jnp
from jax import lax
import numpy as np

D_MODEL = 1024
BATCH = 2
SEQ = 8192
DEPTH = 1

N_HEADS = 8
HEAD_DIM = 64
N_KV_HEADS = 2
GQA_REP = N_HEADS // N_KV_HEADS
D_ATTN = N_HEADS * HEAD_DIM
D_KV = N_KV_HEADS * HEAD_DIM
D_CONV = D_MODEL - D_ATTN
N_CONV_GROUPS = 8
CONV_K = 3
D_MIX = D_ATTN + D_CONV
CMP_BLOCK = 32
CMP_STRIDE = 16
CMP_HIDDEN = 2 * HEAD_DIM
SEL_BLOCK = 64
N_SEL = 16
WINDOW = 512
Q_BLOCK = 128
N_BUCKETS = 32
MAX_DISTANCE = 128
EPS = 1e-6
NEG = -1e30
FORCE_SCORE = 1e3
IN_SPLITS = (D_ATTN, 6 * D_KV, 3 * N_HEADS, D_ATTN, D_CONV, D_CONV, D_CONV, D_CONV)
IN_COLS = sum(IN_SPLITS)

kernel_name = "hymba_nsa_shortconv_hybrid"


def rms_norm(x, w):
    xf = x.astype(jnp.float32)
    y = xf * lax.rsqrt(jnp.mean(xf * xf, axis=-1, keepdims=True) + EPS)
    return (y * w.astype(jnp.float32)).astype(x.dtype)


def t5_bucket(dist):
    n = jnp.maximum(dist, 0)
    max_exact = N_BUCKETS // 2
    nf = jnp.maximum(n, 1).astype(jnp.float32)
    large = max_exact + (jnp.log(nf / max_exact) / math.log(MAX_DISTANCE / max_exact)
                         * (N_BUCKETS - max_exact)).astype(jnp.int32)
    large = jnp.minimum(large, N_BUCKETS - 1)
    return jnp.where(n < max_exact, n, large)


def masked_softmax(s, mask):
    s = jnp.where(mask, s, NEG)
    m = jnp.max(s, axis=-1, keepdims=True)
    p = jnp.where(mask, jnp.exp(s - m), 0.0)
    return p / jnp.maximum(jnp.sum(p, axis=-1, keepdims=True), 1e-30)


def compress(kv, w1, w2, pe):
    b, s, g, dk = kv.shape
    n_chunks = s // CMP_STRIDE
    per_block = CMP_BLOCK // CMP_STRIDE
    n_cmp = n_chunks - per_block + 1
    chunks = kv.reshape(b, n_chunks, CMP_STRIDE, g, dk)
    hid = 0.0
    for m in range(per_block):
        lo, hi = m * CMP_STRIDE, (m + 1) * CMP_STRIDE
        seg = chunks[:, m:m + n_cmp] + pe[lo:hi][None, None, :, None, :]
        hid = hid + jnp.einsum('bcjgd,jdh->bgch', seg, w1[lo:hi])
    return jnp.einsum('bgch,hd->bgcd', jax.nn.silu(hid), w2)


def cmp_to_sel_overlap(n_cmp, n_sel):
    start = np.arange(n_cmp) * CMP_STRIDE
    end = start + CMP_BLOCK
    sel_start = np.arange(n_sel) * SEL_BLOCK
    ov = (start[:, None] < sel_start[None, :] + SEL_BLOCK) & (end[:, None] > sel_start[None, :])
    return jnp.asarray(ov.astype(np.float32))


def nsa_mixer(q, k_cmp, v_cmp, k_slc, v_slc, k_win, v_win, gates,
              w_ck1, w_ck2, pe_k, w_cv1, w_cv2, pe_v, rel_bias):
    b, s = q.shape[:2]
    G, R, dk = N_KV_HEADS, GQA_REP, HEAD_DIM
    qh = (q * (HEAD_DIM ** -0.5)).reshape(b, s, G, R, dk)
    kc = compress(k_cmp, w_ck1, w_ck2, pe_k)
    vc = compress(v_cmp, w_cv1, w_cv2, pe_v)
    n_cmp = kc.shape[2]
    n_sel = s // SEL_BLOCK
    k_top = min(N_SEL, n_sel)
    cmp_end = jnp.arange(n_cmp, dtype=jnp.int32) * CMP_STRIDE + CMP_BLOCK - 1
    overlap = cmp_to_sel_overlap(n_cmp, n_sel)
    ks_blocks = k_slc.transpose(0, 2, 1, 3).reshape(b, G, n_sel, SEL_BLOCK, dk)
    vs_blocks = v_slc.transpose(0, 2, 1, 3).reshape(b, G, n_sel, SEL_BLOCK, dk)
    kw = jnp.pad(k_win.transpose(0, 2, 1, 3), ((0, 0), (0, 0), (WINDOW, 0), (0, 0)))
    vw = jnp.pad(v_win.transpose(0, 2, 1, 3), ((0, 0), (0, 0), (WINDOW, 0), (0, 0)))
    tbl_g = rel_bias.reshape(N_BUCKETS, G, R).transpose(1, 0, 2)
    bi = jnp.arange(b)[:, None, None, None]
    gi = jnp.arange(G)[None, :, None, None]
    sel_ids = jnp.arange(n_sel, dtype=jnp.int32)

    n_qb = s // Q_BLOCK
    q_blocks = qh.reshape(b, n_qb, Q_BLOCK, G, R, dk).transpose(1, 0, 3, 4, 2, 5)
    g_blocks = gates.reshape(b, n_qb, Q_BLOCK, 3, G, R).transpose(1, 3, 0, 4, 5, 2)

    def head_bias(bucket):
        bias = rel_bias[bucket].astype(jnp.float32)
        return bias.transpose(2, 0, 1).reshape(G, R, bucket.shape[0], bucket.shape[1])

    def block_fn(args):
        qb, gb, i = args
        q0 = i * Q_BLOCK
        t = q0 + jnp.arange(Q_BLOCK, dtype=jnp.int32)

        s_c = jnp.einsum('bgrqd,bgcd->bgrqc', qb, kc).astype(jnp.float32)
        dist_c = t[:, None] - cmp_end[None, :]
        p_c = masked_softmax(s_c + head_bias(t5_bucket(dist_c)), dist_c >= 0)
        o_c = jnp.einsum('bgrqc,bgcd->bgrqd', p_c.astype(vc.dtype), vc)

        imp = jnp.einsum('bgrqc,cn->bgqn', p_c, overlap)
        blk_t = t // SEL_BLOCK
        causal_blk = sel_ids[None, :] <= blk_t[:, None]
        forced = (sel_ids[None, :] == 0) | (sel_ids[None, :] == blk_t[:, None]) | (sel_ids[None, :] == blk_t[:, None] - 1)
        score = jnp.where(forced, FORCE_SCORE, jnp.where(causal_blk, imp, -1.0))
        _, idx = lax.top_k(score, k_top)
        k_g = ks_blocks[bi, gi, idx]
        v_g = vs_blocks[bi, gi, idx].reshape(b, G, Q_BLOCK, k_top * SEL_BLOCK, dk)
        s_s = jnp.einsum('bgrqd,bgqnkd->bgrqnk', qb, k_g).astype(jnp.float32)
        pos_s = idx[..., None] * SEL_BLOCK + jnp.arange(SEL_BLOCK, dtype=jnp.int32)
        dist_s = t[None, None, :, None, None] - pos_s
        bias_s = tbl_g[gi[..., None], t5_bucket(dist_s)].astype(jnp.float32)
        bias_s = bias_s.transpose(0, 1, 5, 2, 3, 4)
        flat = (b, G, R, Q_BLOCK, k_top * SEL_BLOCK)
        mask_s = (dist_s >= 0)[:, :, None].reshape(b, G, 1, Q_BLOCK, k_top * SEL_BLOCK)
        p_s = masked_softmax((s_s + bias_s).reshape(flat), mask_s)
        o_s = jnp.einsum('bgrqm,bgqmd->bgrqd', p_s.astype(v_g.dtype), v_g)

        kw_blk = lax.dynamic_slice_in_dim(kw, q0, WINDOW + Q_BLOCK, axis=2)
        vw_blk = lax.dynamic_slice_in_dim(vw, q0, WINDOW + Q_BLOCK, axis=2)
        pos_w = q0 - WINDOW + jnp.arange(WINDOW + Q_BLOCK, dtype=jnp.int32)
        dist_w = t[:, None] - pos_w[None, :]
        mask_w = (dist_w >= 0) & (dist_w < WINDOW) & (pos_w[None, :] >= 0)
        s_w = jnp.einsum('bgrqd,bgkd->bgrqk', qb, kw_blk).astype(jnp.float32)
        p_w = masked_softmax(s_w + head_bias(t5_bucket(dist_w)), mask_w)
        o_w = jnp.einsum('bgrqk,bgkd->bgrqd', p_w.astype(vw_blk.dtype), vw_blk)

        return gb[0][..., None] * o_c + gb[1][..., None] * o_s + gb[2][..., None] * o_w

    out = lax.map(block_fn, (q_blocks, g_blocks, jnp.arange(n_qb, dtype=jnp.int32)))
    return out.transpose(1, 0, 4, 2, 3, 5).reshape(b, s, D_ATTN)


def short_conv_mixer(h, b_gate, c_gate, conv_w):
    u = c_gate * h
    y = lax.conv_general_dilated(u, conv_w[:, None, :].astype(u.dtype), window_strides=(1,),
                                 padding=[(CONV_K - 1, 0)],
                                 dimension_numbers=('NWC', 'WIO', 'NWC'),
                                 feature_group_count=D_CONV)
    return b_gate * y


def setup_inputs(seed: int = 0) -> dict:
    key = jax.random.key(seed)
    ks = jax.random.split(key, 16)
    f32 = jnp.float32
    nrm = lambda k, shape, scale: jax.random.normal(k, shape, f32) * scale
    return {
        "x": nrm(ks[0], (BATCH, SEQ, D_MODEL), 1.0),
        "norm_w": 1.0 + nrm(ks[1], (DEPTH, D_MODEL), 0.01),
        "w_in": nrm(ks[2], (DEPTH, D_MODEL, IN_COLS), D_MODEL ** -0.5),
        "w_ck1": nrm(ks[3], (DEPTH, CMP_BLOCK, HEAD_DIM, CMP_HIDDEN), (CMP_BLOCK * HEAD_DIM) ** -0.5),
        "w_ck2": nrm(ks[4], (DEPTH, CMP_HIDDEN, HEAD_DIM), CMP_HIDDEN ** -0.5),
        "pe_k": nrm(ks[5], (DEPTH, CMP_BLOCK, HEAD_DIM), 0.02),
        "w_cv1": nrm(ks[6], (DEPTH, CMP_BLOCK, HEAD_DIM, CMP_HIDDEN), (CMP_BLOCK * HEAD_DIM) ** -0.5),
        "w_cv2": nrm(ks[7], (DEPTH, CMP_HIDDEN, HEAD_DIM), CMP_HIDDEN ** -0.5),
        "pe_v": nrm(ks[8], (DEPTH, CMP_BLOCK, HEAD_DIM), 0.02),
        "conv_w": nrm(ks[9], (DEPTH, CONV_K, D_CONV), CONV_K ** -0.5),
        "w_out": nrm(ks[10], (DEPTH, D_MIX, D_MODEL), D_MIX ** -0.5),
        "rel_bias": nrm(ks[11], (N_BUCKETS, N_HEADS), 0.5),
        "final_norm_w": 1.0 + nrm(ks[12], (D_MODEL,), 0.01),
    }


def reference(x, norm_w, w_in, w_ck1, w_ck2, pe_k, w_cv1, w_cv2, pe_v, conv_w, w_out,
              rel_bias, final_norm_w):
    b, s, _ = x.shape
    split_at = [int(c) for c in np.cumsum(IN_SPLITS)[:-1]]
    for l in range(DEPTH):
        h = rms_norm(x, norm_w[l])
        proj = h @ w_in[l]
        q, kv, gate_logits, z_attn, conv_h, conv_b, conv_c, z_conv = jnp.split(proj, split_at, axis=-1)
        k_cmp, v_cmp, k_slc, v_slc, k_win, v_win = [
            a.reshape(b, s, N_KV_HEADS, HEAD_DIM) for a in jnp.split(kv, 6, axis=-1)]
        gates = jax.nn.sigmoid(gate_logits).reshape(b, s, 3, N_HEADS)
        attn = nsa_mixer(q.reshape(b, s, N_HEADS, HEAD_DIM), k_cmp, v_cmp, k_slc, v_slc,
                         k_win, v_win, gates, w_ck1[l], w_ck2[l], pe_k[l],
                         w_cv1[l], w_cv2[l], pe_v[l], rel_bias)
        conv = short_conv_mixer(conv_h, conv_b, conv_c, conv_w[l])
        mixed = jnp.concatenate([attn * jax.nn.silu(z_attn), conv * jax.nn.silu(z_conv)], axis=-1)
        x = x + mixed @ w_out[l]
    return rms_norm(x, final_norm_w)
```

```cpp
#ifndef HOST_EMU
#include <hip/hip_runtime.h>
#include <cstdio>
#include <cstdint>
#include <cstring>
#define HD __host__ __device__ __forceinline__
#else
#include <cmath>
#include <cstdio>
#include <cstdint>
#include <cstring>
#define HD static inline
#endif

#ifndef SEQ
#define SEQ 8192
#endif
typedef unsigned short bf16;
constexpr int NB = 2, S = SEQ, DM = 1024, NH = 8, HDIM = 64, NG = 2, NR = 4, DATT = 512, DCONV = 512;
constexpr int INCOLS = 3864, NP = 3968, NCMP = S / 16 - 1, NCP = S / 16, NSEL = S / 64, KTOP = (NSEL < 16 ? NSEL : 16);
constexpr int WIN = 512, ROWS = NB * S;

HD float bf2f(bf16 v) { union { unsigned u; float f; } c; c.u = ((unsigned)v) << 16; return c.f; }
HD bf16 f2bf(float f) { union { unsigned u; float f; } c; c.f = f; unsigned u = c.u; unsigned r = u + 0x7FFFu + ((u >> 16) & 1u); return (bf16)(r >> 16); }
HD float siluf(float v) { return v / (1.f + expf(-v)); }
HD float sigmf(float v) { return 1.f / (1.f + expf(-v)); }

struct Params {
    const float *x, *norm_w, *w_in, *w_ck1, *w_ck2, *pe_k, *w_cv1, *w_cv2, *pe_v, *conv_w, *w_out, *rel_bias, *fnw;
    float* out;
    unsigned* bar;
    bf16 *wt_in, *wt_out, *w1t[2], *w2t[2];
    float *peb[2], *bias_tab;
    bf16* xb; float* rstd;
    bf16 *q, *kv[6], *reg5[5];
    float* gates;
    float* hid;
    bf16* kcvc[2];
    float* imp; int* idx; float* attn_acc; bf16* mixed;
};

HD int t5_bucket(int d) {
    if (d >= 128) return 31;
    const unsigned long long lo = 0x81041088929fffeull, hi = 0x2000800802008ull;
    if (d < 64) return __builtin_popcountll(lo & ((2ull << d) - 1ull));
    return __builtin_popcountll(lo) + __builtin_popcountll(hi & ((2ull << (d - 64)) - 1ull));
}
HD int src_col(int n) { return n < 1280 ? n : (n < 3840 ? n + 24 : (n < 3864 ? 1280 + (n - 3840) : -1)); }
HD void prep_wtin_body(const Params& p, long gid) {
    const int n = (int)(gid / DM), k = (int)(gid % DM); const int c = src_col(n);
    p.wt_in[gid] = c < 0 ? (bf16)0 : f2bf(p.norm_w[k] * p.w_in[(long)k * INCOLS + c]);
}
HD void prep_wtout_body(const Params& p, long gid) {
    const int n = (int)(gid / DM), k = (int)(gid % DM);
    p.wt_out[gid] = f2bf(p.w_out[(long)k * DM + n]);
}
HD void prep_w1t_body(const Params& p, long gid) {
    const int w = (int)(gid / (128 * 2048)), r = (int)(gid % (128 * 2048)), h = r / 2048, jd = r % 2048;
    const float* w1 = w ? p.w_cv1 : p.w_ck1;
    p.w1t[w][r] = f2bf(w1[(long)jd * 128 + h]);
}
HD void prep_w2t_body(const Params& p, long gid) {
    const int w = (int)(gid / (64 * 128)), r = (int)(gid % (64 * 128)), d = r / 128, h = r % 128;
    const float* w2 = w ? p.w_cv2 : p.w_ck2;
    p.w2t[w][r] = f2bf(w2[h * 64 + d]);
}
HD void prep_peb_body(const Params& p, long gid) {
    const int w = (int)(gid / 128), h = (int)(gid % 128);
    const float* w1 = w ? p.w_cv1 : p.w_ck1; const float* pe = w ? p.pe_v : p.pe_k;
    float a = 0.f; for (int jd = 0; jd < 2048; ++jd) a += pe[jd] * w1[(long)jd * 128 + h];
    p.peb[w][h] = a;
}
HD void prep_bias_body(const Params& p, long gid) {
    const int d = (int)(gid / 8), h = (int)(gid % 8); const int bk = t5_bucket(d);
    p.bias_tab[gid] = p.rel_bias[bk * 8 + h];
}
HD void prep_x_body(const Params& p, long row) {
    const float* xr = p.x + row * DM; float ss = 0.f;
    for (int k = 0; k < DM; ++k) { const float v = xr[k]; ss += v * v; p.xb[row * DM + k] = f2bf(v); }
    p.rstd[row] = 1.0f / sqrtf(ss / DM + 1e-6f);
}
HD void store_proj(const Params& p, int row, int n, float v) {
    const int b = row / S, s = row % S;
    if (n < 512) { const int h = n >> 6, d = n & 63; p.q[(((long)b * NH + h) * S + s) * 64 + d] = f2bf(v * 0.125f); }
    else if (n < 1280) { const int j = (n - 512) >> 7, g = ((n - 512) >> 6) & 1, d = n & 63; p.kv[j][(((long)b * NG + g) * S + s) * 64 + d] = f2bf(v); }
    else if (n < 3840) { const int r = (n - 1280) >> 9, c = (n - 1280) & 511; p.reg5[r][((long)b * S + s) * 512 + c] = f2bf(v); }
    else if (n < 3864) { p.gates[((long)b * S + s) * 24 + (n - 3840)] = sigmf(v); }
}
HD void compress1_body(const Params& p, long gid) {
    const int h = (int)(gid % 128); long r = gid / 128; const int c = (int)(r % NCMP); r /= NCMP; const int g = (int)(r % NG); r /= NG; const int b = (int)(r % NB); const int w = (int)(r / NB);
    const bf16* src = p.kv[w] + (((long)b * NG + g) * S + 16 * c) * 64;
    const bf16* wr = p.w1t[w] + (long)h * 2048;
    float a = p.peb[w][h];
    for (int jd = 0; jd < 2048; ++jd) a += bf2f(src[jd]) * bf2f(wr[jd]);
    p.hid[((((long)w * NB + b) * NG + g) * NCP + c) * 128 + h] = a;
}
HD void compress2_body(const Params& p, long gid) {
    const int d = (int)(gid % 64); long r = gid / 64; const int c = (int)(r % NCMP); r /= NCMP; const int g = (int)(r % NG); r /= NG; const int b = (int)(r % NB); const int w = (int)(r / NB);
    const float* hp = p.hid + ((((long)w * NB + b) * NG + g) * NCP + c) * 128;
    const bf16* wr = p.w2t[w] + d * 128;
    float a = 0.f;
    for (int h = 0; h < 128; ++h) a += bf2f(f2bf(siluf(hp[h]))) * bf2f(wr[h]);
    p.kcvc[w][(((long)b * NG + g) * NCP + c) * 64 + d] = f2bf(a);
}
HD float dot64(const float* q, const bf16* k) { float a = 0.f;
#pragma unroll
    for (int d = 0; d < 64; ++d) a += q[d] * bf2f(k[d]);
    return a; }

HD void cmp_body(const Params& p, long gid) {
    const int t = (int)(gid % S); const int g = (int)((gid / S) % NG); const int b = (int)(gid / ((long)S * NG));
    const int nv = t >= 31 ? (t - 31) / 16 + 1 : 0;
    float* imp = p.imp + gid * 128;
    for (int n = 0; n < 128; ++n) imp[n] = 0.f;
    const bf16* kc = p.kcvc[0] + ((long)b * NG + g) * NCP * 64;
    const bf16* vc = p.kcvc[1] + ((long)b * NG + g) * NCP * 64;
    for (int r = 0; r < NR; ++r) {
        const int h = g * NR + r;
        const bf16* qp = p.q + (((long)b * NH + h) * S + t) * 64;
        float q[64], o[64];
#pragma unroll
        for (int d = 0; d < 64; ++d) { q[d] = bf2f(qp[d]); o[d] = 0.f; }
        float m = -1e30f;
        for (int c = 0; c < nv; ++c) { const int dist = t - (16 * c + 31); const float s = dot64(q, kc + c * 64) + p.bias_tab[(dist < 128 ? dist : 128) * 8 + h]; m = fmaxf(m, s); }
        float l = 0.f;
        for (int c = 0; c < nv; ++c) { const int dist = t - (16 * c + 31); const float s = dot64(q, kc + c * 64) + p.bias_tab[(dist < 128 ? dist : 128) * 8 + h]; l += expf(s - m); }
        const float inv = 1.f / fmaxf(l, 1e-30f);
        for (int c = 0; c < nv; ++c) {
            const int dist = t - (16 * c + 31); const float s = dot64(q, kc + c * 64) + p.bias_tab[(dist < 128 ? dist : 128) * 8 + h];
            const float pr = expf(s - m) * inv;
#pragma unroll
            for (int d = 0; d < 64; ++d) o[d] += pr * bf2f(vc[c * 64 + d]);
            imp[c >> 2] += pr; if ((c & 3) == 3) imp[(c >> 2) + 1] += pr;
        }
        const float g0 = p.gates[((long)b * S + t) * 24 + 0 * 8 + h];
        float* ao = p.attn_acc + ((long)b * S + t) * 512 + h * 64;
#pragma unroll
        for (int d = 0; d < 64; ++d) ao[d] = g0 * o[d];
    }
    const int blk = t >> 6;
    for (int n = 0; n < NSEL; ++n) { const bool forced = (n == 0) || (n == blk) || (n == blk - 1); imp[n] = forced ? 1e3f : (n <= blk ? imp[n] : -1.0f); }
    int* idx = p.idx + gid * 16;
    for (int k = 0; k < KTOP; ++k) {
        float best = -3e38f; int bi = 0;
        for (int n = 0; n < NSEL; ++n) { const float v = imp[n]; if (v > best) { best = v; bi = n; } }
        idx[k] = bi; imp[bi] = -3.4e38f;
    }
}
HD void slcwin_body(const Params& p, long gid) {
    const int t = (int)(gid % S); const int h = (int)((gid / S) % NH); const int b = (int)(gid / ((long)S * NH)); const int g = h / NR;
    const bf16* qp = p.q + (((long)b * NH + h) * S + t) * 64;
    float q[64], o[64];
#pragma unroll
    for (int d = 0; d < 64; ++d) { q[d] = bf2f(qp[d]); o[d] = 0.f; }
    const long kvoff = ((long)b * NG + g) * S * 64;
    float acc[64];
    const float* ai = p.attn_acc + ((long)b * S + t) * 512 + h * 64;
#pragma unroll
    for (int d = 0; d < 64; ++d) acc[d] = ai[d];
    {
        const bf16* K = p.kv[2] + kvoff; const bf16* V = p.kv[3] + kvoff;
        const int* idx = p.idx + (((long)b * NG + g) * S + t) * 16;
        float m = -1e30f, l = 0.f;
        for (int k = 0; k < KTOP; ++k) {
            const int n = idx[k];
            for (int j = 0; j < 64; ++j) {
                const int pos = n * 64 + j, dist = t - pos; if (dist < 0) continue;
                const float s = dot64(q, K + (long)pos * 64) + p.bias_tab[(dist < 128 ? dist : 128) * 8 + h];
                if (s > m) { const float f = expf(m - s); l *= f;
#pragma unroll
                    for (int d = 0; d < 64; ++d) o[d] *= f;
                    m = s; }
                const float pr = expf(s - m); l += pr;
#pragma unroll
                for (int d = 0; d < 64; ++d) o[d] += pr * bf2f(V[(long)pos * 64 + d]);
            }
        }
        const float g1 = p.gates[((long)b * S + t) * 24 + 1 * 8 + h] / fmaxf(l, 1e-30f);
#pragma unroll
        for (int d = 0; d < 64; ++d) { acc[d] += g1 * o[d]; o[d] = 0.f; }
    }
    {
        const bf16* K = p.kv[4] + kvoff; const bf16* V = p.kv[5] + kvoff;
        float m = -1e30f, l = 0.f;
        const int lo = t - (WIN - 1) > 0 ? t - (WIN - 1) : 0;
        for (int pos = lo; pos <= t; ++pos) {
            const int dist = t - pos;
            const float s = dot64(q, K + (long)pos * 64) + p.bias_tab[(dist < 128 ? dist : 128) * 8 + h];
            if (s > m) { const float f = expf(m - s); l *= f;
#pragma unroll
                for (int d = 0; d < 64; ++d) o[d] *= f;
                m = s; }
            const float pr = expf(s - m); l += pr;
#pragma unroll
            for (int d = 0; d < 64; ++d) o[d] += pr * bf2f(V[(long)pos * 64 + d]);
        }
        const float g2 = p.gates[((long)b * S + t) * 24 + 2 * 8 + h] / fmaxf(l, 1e-30f);
#pragma unroll
        for (int d = 0; d < 64; ++d) acc[d] += g2 * o[d];
    }
    const bf16* z = p.reg5[0] + ((long)b * S + t) * 512 + h * 64;
    bf16* mo = p.mixed + ((long)b * S + t) * 1024 + h * 64;
#pragma unroll
    for (int d = 0; d < 64; ++d) mo[d] = f2bf(acc[d] * siluf(bf2f(z[d])));
}
HD void conv_body(const Params& p, long gid) {
    const int ch = (int)(gid % 512); const int t = (int)((gid / 512) % S); const int b = (int)(gid / (512L * S));
    const long base = ((long)b * S + t) * 512 + ch;
    float y = 0.f;
    for (int k = 0; k < 3; ++k) { const int tt = t - 2 + k; if (tt < 0) continue; const long o = base - (long)(2 - k) * 512;
        y += p.conv_w[k * 512 + ch] * (bf2f(p.reg5[3][o]) * bf2f(p.reg5[1][o])); }
    const float v = bf2f(p.reg5[2][base]) * y * siluf(bf2f(p.reg5[4][base]));
    p.mixed[((long)b * S + t) * 1024 + 512 + ch] = f2bf(v);
}
HD void final_norm_body(const Params& p, long row) {
    float* yr = p.out + row * DM; float ss = 0.f;
    for (int k = 0; k < DM; ++k) ss += yr[k] * yr[k];
    const float r = 1.0f / sqrtf(ss / DM + 1e-6f);
    for (int k = 0; k < DM; ++k) yr[k] = yr[k] * r * p.fnw[k];
}

static inline size_t carve(Params& p, char* base) {
    size_t off = 0; auto take = [&](size_t bytes) { char* r = base ? base + off : nullptr; off += (bytes + 255) & ~(size_t)255; return r; };
    p.bar = (unsigned*)take(16384);
    p.wt_in = (bf16*)take((size_t)NP * DM * 2); p.wt_out = (bf16*)take((size_t)DM * DM * 2);
    for (int w = 0; w < 2; ++w) p.w1t[w] = (bf16*)take(128 * 2048 * 2);
    for (int w = 0; w < 2; ++w) p.w2t[w] = (bf16*)take(64 * 128 * 2);
    for (int w = 0; w < 2; ++w) p.peb[w] = (float*)take(128 * 4);
    p.bias_tab = (float*)take(129 * 8 * 4);
    p.xb = (bf16*)take((size_t)ROWS * DM * 2); p.attn_acc = (float*)p.xb;
    p.rstd = (float*)take((size_t)ROWS * 4);
    p.q = (bf16*)take((size_t)NB * NH * S * 64 * 2);
    for (int j = 0; j < 6; ++j) p.kv[j] = (bf16*)take((size_t)NB * NG * S * 64 * 2);
    for (int j = 0; j < 5; ++j) p.reg5[j] = (bf16*)take((size_t)ROWS * 512 * 2);
    p.gates = (float*)take((size_t)ROWS * 24 * 4);
    p.hid = (float*)take((size_t)2 * NB * NG * NCP * 128 * 4);
    for (int w = 0; w < 2; ++w) p.kcvc[w] = (bf16*)take((size_t)NB * NG * NCP * 64 * 2);
    p.imp = (float*)take((size_t)NB * NG * S * 128 * 4);
    p.idx = (int*)take((size_t)NB * NG * S * 16 * 4);
    p.mixed = (bf16*)take((size_t)ROWS * 1024 * 2);
    return off;
}

#ifndef HOST_EMU
#define NAIVE_KERNEL(name) __global__ void __launch_bounds__(256) k_##name(Params p, long n) { const long gid = (long)blockIdx.x * 256 + threadIdx.x; if (gid < n) name##_body(p, gid); }
NAIVE_KERNEL(prep_wtin) NAIVE_KERNEL(prep_wtout) NAIVE_KERNEL(prep_w1t) NAIVE_KERNEL(prep_w2t) NAIVE_KERNEL(prep_peb) NAIVE_KERNEL(prep_bias) NAIVE_KERNEL(prep_x)
NAIVE_KERNEL(compress1) NAIVE_KERNEL(compress2) NAIVE_KERNEL(cmp) NAIVE_KERNEL(slcwin) NAIVE_KERNEL(conv) NAIVE_KERNEL(final_norm)

typedef short bf16x8 __attribute__((ext_vector_type(8)));
typedef float f32x4 __attribute__((ext_vector_type(4)));
template <int MODE> __global__ void __launch_bounds__(256) k_gemm(Params p, const bf16* A, const bf16* Bt, int M, int N, int K) {
    const int wave = threadIdx.x >> 6, lane = threadIdx.x & 63, c = lane & 15, g = lane >> 4;
    const int tilesN = N / 64; const long tile = (long)blockIdx.x * 4 + wave; if (tile >= (long)(M / 64) * tilesN) return;
    const int m0 = (int)(tile / tilesN) * 64, n0 = (int)(tile % tilesN) * 64;
    f32x4 acc[4][4];
#pragma unroll
    for (int i = 0; i < 4; ++i)
#pragma unroll
        for (int j = 0; j < 4; ++j) acc[i][j] = (f32x4){0.f, 0.f, 0.f, 0.f};
    for (int k0 = 0; k0 < K; k0 += 32) {
        bf16x8 a[4], bb[4];
#pragma unroll
        for (int i = 0; i < 4; ++i) a[i] = *(const bf16x8*)(A + (long)(m0 + 16 * i + c) * K + k0 + 8 * g);
#pragma unroll
        for (int j = 0; j < 4; ++j) bb[j] = *(const bf16x8*)(Bt + (long)(n0 + 16 * j + c) * K + k0 + 8 * g);
#pragma unroll
        for (int i = 0; i < 4; ++i)
#pragma unroll
            for (int j = 0; j < 4; ++j) acc[i][j] = __builtin_amdgcn_mfma_f32_16x16x32_bf16(a[i], bb[j], acc[i][j], 0, 0, 0);
    }
#pragma unroll
    for (int i = 0; i < 4; ++i)
#pragma unroll
        for (int j = 0; j < 4; ++j)
#pragma unroll
            for (int r = 0; r < 4; ++r) {
                const int row = m0 + 16 * i + 4 * g + r, col = n0 + 16 * j + c; const float v = acc[i][j][r];
                if (MODE == 0) store_proj(p, row, col, v * p.rstd[row]);
                else p.out[(long)row * DM + col] = p.x[(long)row * DM + col] + v;
            }
}

extern "C" void kernel_launch(void* const* d_in, const int* in_sizes, int n_in, void* d_out, int out_size, void* d_ws, size_t ws_size, hipStream_t stream) {
    Params p; memset(&p, 0, sizeof(p));
    const float** ins[13] = {&p.x, &p.norm_w, &p.w_in, &p.w_ck1, &p.w_ck2, &p.pe_k, &p.w_cv1, &p.w_cv2, &p.pe_v, &p.conv_w, &p.w_out, &p.rel_bias, &p.fnw};
    for (int i = 0; i < 13; ++i) *ins[i] = (const float*)d_in[i];
    p.out = (float*)d_out;
    const size_t need = carve(p, (char*)d_ws);
    if (need > ws_size) { fprintf(stderr, "workspace too small: need %zu have %zu\n", need, ws_size); return; }
#define LAUNCH(name, n) hipLaunchKernelGGL(k_##name, dim3((unsigned)(((long)(n) + 255) / 256)), dim3(256), 0, stream, p, (long)(n))
    LAUNCH(prep_wtin, (long)NP * DM); LAUNCH(prep_wtout, (long)DM * DM); LAUNCH(prep_w1t, 2L * 128 * 2048); LAUNCH(prep_w2t, 2L * 64 * 128);
    LAUNCH(prep_peb, 256); LAUNCH(prep_bias, 129 * 8); LAUNCH(prep_x, ROWS);
    hipLaunchKernelGGL(k_gemm<0>, dim3((ROWS / 64) * (NP / 64) / 4), dim3(256), 0, stream, p, (const bf16*)p.xb, (const bf16*)p.wt_in, ROWS, NP, DM);
    LAUNCH(compress1, 2L * NB * NG * NCMP * 128); LAUNCH(compress2, 2L * NB * NG * NCMP * 64);
    LAUNCH(cmp, (long)NB * NG * S); LAUNCH(slcwin, (long)NB * NH * S); LAUNCH(conv, (long)NB * S * 512);
    hipLaunchKernelGGL(k_gemm<1>, dim3((ROWS / 64) * (DM / 64) / 4), dim3(256), 0, stream, p, (const bf16*)p.mixed, (const bf16*)p.wt_out, ROWS, DM, DM);
    LAUNCH(final_norm, ROWS);
}
#endif
```

```cpp
#ifndef HOST_EMU
#include <hip/hip_runtime.h>
#include <cstdio>
#include <cstdint>
#include <cstring>
#define HD __host__ __device__ __forceinline__
#else
#include <cmath>
#include <cstdio>
#include <cstdint>
#include <cstring>
#define HD static inline
#endif

#ifndef SEQ
#define SEQ 8192
#endif
typedef unsigned short bf16;
constexpr int NB = 2, S = SEQ, DM = 1024, NH = 8, HDIM = 64, NG = 2, NR = 4, DATT = 512, DCONV = 512;
constexpr int INCOLS = 3864, NP = 3968, NCMP = S / 16 - 1, NCP = S / 16, NSEL = S / 64, KTOP = (NSEL < 16 ? NSEL : 16);
constexpr int WIN = 512, ROWS = NB * S;

HD float bf2f(bf16 v) { union { unsigned u; float f; } c; c.u = ((unsigned)v) << 16; return c.f; }
HD bf16 f2bf(float f) { union { unsigned u; float f; } c; c.f = f; unsigned u = c.u; unsigned r = u + 0x7FFFu + ((u >> 16) & 1u); return (bf16)(r >> 16); }
HD float siluf(float v) { return v / (1.f + expf(-v)); }
HD float sigmf(float v) { return 1.f / (1.f + expf(-v)); }

struct Params {
    const float *x, *norm_w, *w_in, *w_ck1, *w_ck2, *pe_k, *w_cv1, *w_cv2, *pe_v, *conv_w, *w_out, *rel_bias, *fnw;
    float* out;
    unsigned* bar;
    bf16 *wt_in, *wt_out, *w1t[2], *w2t[2];
    float *peb[2], *bias_tab;
    bf16* xb; float* rstd;
    bf16 *q, *kv[6], *reg5[5];
    float* gates;
    float* hid;
    bf16* kcvc[2];
    float* imp; int* idx; float* attn_acc; bf16* mixed;
};

HD int t5_bucket(int d) {
    if (d >= 128) return 31;
    const unsigned long long lo = 0x81041088929fffeull, hi = 0x2000800802008ull;
    if (d < 64) return __builtin_popcountll(lo & ((2ull << d) - 1ull));
    return __builtin_popcountll(lo) + __builtin_popcountll(hi & ((2ull << (d - 64)) - 1ull));
}
HD int src_col(int n) { return n < 1280 ? n : (n < 3840 ? n + 24 : (n < 3864 ? 1280 + (n - 3840) : -1)); }
HD void prep_wtin_body(const Params& p, long gid) {
    const int n = (int)(gid / DM), k = (int)(gid % DM); const int c = src_col(n);
    p.wt_in[gid] = c < 0 ? (bf16)0 : f2bf(p.norm_w[k] * p.w_in[(long)k * INCOLS + c]);
}
HD void prep_wtout_body(const Params& p, long gid) {
    const int n = (int)(gid / DM), k = (int)(gid % DM);
    p.wt_out[gid] = f2bf(p.w_out[(long)k * DM + n]);
}
HD void prep_w1t_body(const Params& p, long gid) {
    const int w = (int)(gid / (128 * 2048)), r = (int)(gid % (128 * 2048)), h = r / 2048, jd = r % 2048;
    const float* w1 = w ? p.w_cv1 : p.w_ck1;
    p.w1t[w][r] = f2bf(w1[(long)jd * 128 + h]);
}
HD void prep_w2t_body(const Params& p, long gid) {
    const int w = (int)(gid / (64 * 128)), r = (int)(gid % (64 * 128)), d = r / 128, h = r % 128;
    const float* w2 = w ? p.w_cv2 : p.w_ck2;
    p.w2t[w][r] = f2bf(w2[h * 64 + d]);
}
HD void prep_peb_body(const Params& p, long gid) {
    const int w = (int)(gid / 128), h = (int)(gid % 128);
    const float* w1 = w ? p.w_cv1 : p.w_ck1; const float* pe = w ? p.pe_v : p.pe_k;
    float a = 0.f; for (int jd = 0; jd < 2048; ++jd) a += pe[jd] * w1[(long)jd * 128 + h];
    p.peb[w][h] = a;
}
HD void prep_bias_body(const Params& p, long gid) {
    const int d = (int)(gid / 8), h = (int)(gid % 8); const int bk = t5_bucket(d);
    p.bias_tab[gid] = p.rel_bias[bk * 8 + h];
}
HD void prep_x_body(const Params& p, long row) {
    const float* xr = p.x + row * DM; float ss = 0.f;
    for (int k = 0; k < DM; ++k) { const float v = xr[k]; ss += v * v; p.xb[row * DM + k] = f2bf(v); }
    p.rstd[row] = 1.0f / sqrtf(ss / DM + 1e-6f);
}
HD void store_proj(const Params& p, int row, int n, float v) {
    const int b = row / S, s = row % S;
    if (n < 512) { const int h = n >> 6, d = n & 63; p.q[(((long)b * NH + h) * S + s) * 64 + d] = f2bf(v * 0.125f); }
    else if (n < 1280) { const int j = (n - 512) >> 7, g = ((n - 512) >> 6) & 1, d = n & 63; p.kv[j][(((long)b * NG + g) * S + s) * 64 + d] = f2bf(v); }
    else if (n < 3840) { const int r = (n - 1280) >> 9, c = (n - 1280) & 511; p.reg5[r][((long)b * S + s) * 512 + c] = f2bf(v); }
    else if (n < 3864) { p.gates[((long)b * S + s) * 24 + (n - 3840)] = sigmf(v); }
}
HD void compress1_body(const Params& p, long gid) {
    const int h = (int)(gid % 128); long r = gid / 128; const int c = (int)(r % NCMP); r /= NCMP; const int g = (int)(r % NG); r /= NG; const int b = (int)(r % NB); const int w = (int)(r / NB);
    const bf16* src = p.kv[w] + (((long)b * NG + g) * S + 16 * c) * 64;
    const bf16* wr = p.w1t[w] + (long)h * 2048;
    float a = p.peb[w][h];
    for (int jd = 0; jd < 2048; ++jd) a += bf2f(src[jd]) * bf2f(wr[jd]);
    p.hid[((((long)w * NB + b) * NG + g) * NCP + c) * 128 + h] = a;
}
HD void compress2_body(const Params& p, long gid) {
    const int d = (int)(gid % 64); long r = gid / 64; const int c = (int)(r % NCMP); r /= NCMP; const int g = (int)(r % NG); r /= NG; const int b = (int)(r % NB); const int w = (int)(r / NB);
    const float* hp = p.hid + ((((long)w * NB + b) * NG + g) * NCP + c) * 128;
    const bf16* wr = p.w2t[w] + d * 128;
    float a = 0.f;
    for (int h = 0; h < 128; ++h) a += bf2f(f2bf(siluf(hp[h]))) * bf2f(wr[h]);
    p.kcvc[w][(((long)b * NG + g) * NCP + c) * 64 + d] = f2bf(a);
}
HD float dot64(const float* q, const bf16* k) { float a = 0.f;
#pragma unroll
    for (int d = 0; d < 64; ++d) a += q[d] * bf2f(k[d]);
    return a; }

HD void cmp_body(const Params& p, long gid) {
    const int t = (int)(gid % S); const int g = (int)((gid / S) % NG); const int b = (int)(gid / ((long)S * NG));
    const int nv = t >= 31 ? (t - 31) / 16 + 1 : 0;
    float* imp = p.imp + gid * 128;
    for (int n = 0; n < 128; ++n) imp[n] = 0.f;
    const bf16* kc = p.kcvc[0] + ((long)b * NG + g) * NCP * 64;
    const bf16* vc = p.kcvc[1] + ((long)b * NG + g) * NCP * 64;
    for (int r = 0; r < NR; ++r) {
        const int h = g * NR + r;
        const bf16* qp = p.q + (((long)b * NH + h) * S + t) * 64;
        float q[64], o[64];
#pragma unroll
        for (int d = 0; d < 64; ++d) { q[d] = bf2f(qp[d]); o[d] = 0.f; }
        float m = -1e30f;
        for (int c = 0; c < nv; ++c) { const int dist = t - (16 * c + 31); const float s = dot64(q, kc + c * 64) + p.bias_tab[(dist < 128 ? dist : 128) * 8 + h]; m = fmaxf(m, s); }
        float l = 0.f;
        for (int c = 0; c < nv; ++c) { const int dist = t - (16 * c + 31); const float s = dot64(q, kc + c * 64) + p.bias_tab[(dist < 128 ? dist : 128) * 8 + h]; l += expf(s - m); }
        const float inv = 1.f / fmaxf(l, 1e-30f);
        for (int c = 0; c < nv; ++c) {
            const int dist = t - (16 * c + 31); const float s = dot64(q, kc + c * 64) + p.bias_tab[(dist < 128 ? dist : 128) * 8 + h];
            const float pr = expf(s - m) * inv;
#pragma unroll
            for (int d = 0; d < 64; ++d) o[d] += pr * bf2f(vc[c * 64 + d]);
            imp[c >> 2] += pr; if ((c & 3) == 3) imp[(c >> 2) + 1] += pr;
        }
        const float g0 = p.gates[((long)b * S + t) * 24 + 0 * 8 + h];
        float* ao = p.attn_acc + ((long)b * S + t) * 512 + h * 64;
#pragma unroll
        for (int d = 0; d < 64; ++d) ao[d] = g0 * o[d];
    }
    const int blk = t >> 6;
    for (int n = 0; n < NSEL; ++n) { const bool forced = (n == 0) || (n == blk) || (n == blk - 1); imp[n] = forced ? 1e3f : (n <= blk ? imp[n] : -1.0f); }
    int* idx = p.idx + gid * 16;
    for (int k = 0; k < KTOP; ++k) {
        float best = -3e38f; int bi = 0;
        for (int n = 0; n < NSEL; ++n) { const float v = imp[n]; if (v > best) { best = v; bi = n; } }
        idx[k] = bi; imp[bi] = -3.4e38f;
    }
}
HD void slcwin_body(const Params& p, long gid) {
    const int t = (int)(gid % S); const int h = (int)((gid / S) % NH); const int b = (int)(gid / ((long)S * NH)); const int g = h / NR;
    const bf16* qp = p.q + (((long)b * NH + h) * S + t) * 64;
    float q[64], o[64];
#pragma unroll
    for (int d = 0; d < 64; ++d) { q[d] = bf2f(qp[d]); o[d] = 0.f; }
    const long kvoff = ((long)b * NG + g) * S * 64;
    float* ai = p.attn_acc + ((long)b * S + t) * 512 + h * 64;
    {
        const bf16* K = p.kv[2] + kvoff; const bf16* V = p.kv[3] + kvoff;
        const int* idx = p.idx + (((long)b * NG + g) * S + t) * 16;
        float m = -1e30f, l = 0.f;
        for (int k = 0; k < KTOP; ++k) {
            const int n = idx[k];
            for (int j = 0; j < 64; ++j) {
                const int pos = n * 64 + j, dist = t - pos; if (dist < 0) continue;
                const float s = dot64(q, K + (long)pos * 64) + p.bias_tab[(dist < 128 ? dist : 128) * 8 + h];
                if (s > m) { const float f = expf(m - s); l *= f;
#pragma unroll
                    for (int d = 0; d < 64; ++d) o[d] *= f;
                    m = s; }
                const float pr = expf(s - m); l += pr;
#pragma unroll
                for (int d = 0; d < 64; ++d) o[d] += pr * bf2f(V[(long)pos * 64 + d]);
            }
        }
        const float g1 = p.gates[((long)b * S + t) * 24 + 1 * 8 + h] / fmaxf(l, 1e-30f);
#pragma unroll
        for (int d = 0; d < 64; ++d) { ai[d] += g1 * o[d]; o[d] = 0.f; }
    }
    {
        const bf16* K = p.kv[4] + kvoff; const bf16* V = p.kv[5] + kvoff;
        float m = -1e30f, l = 0.f;
        const int lo = t - (WIN - 1) > 0 ? t - (WIN - 1) : 0;
        for (int pos = lo; pos <= t; ++pos) {
            const int dist = t - pos;
            const float s = dot64(q, K + (long)pos * 64) + p.bias_tab[(dist < 128 ? dist : 128) * 8 + h];
            if (s > m) { const float f = expf(m - s); l *= f;
#pragma unroll
                for (int d = 0; d < 64; ++d) o[d] *= f;
                m = s; }
            const float pr = expf(s - m); l += pr;
#pragma unroll
            for (int d = 0; d < 64; ++d) o[d] += pr * bf2f(V[(long)pos * 64 + d]);
        }
        const float g2 = p.gates[((long)b * S + t) * 24 + 2 * 8 + h] / fmaxf(l, 1e-30f);
        const bf16* z = p.reg5[0] + ((long)b * S + t) * 512 + h * 64;
        bf16* mo = p.mixed + ((long)b * S + t) * 1024 + h * 64;
#pragma unroll
        for (int d = 0; d < 64; ++d) mo[d] = f2bf((ai[d] + g2 * o[d]) * siluf(bf2f(z[d])));
    }
}
HD void conv_body(const Params& p, long gid) {
    const int ch = (int)(gid % 512); const int t = (int)((gid / 512) % S); const int b = (int)(gid / (512L * S));
    const long base = ((long)b * S + t) * 512 + ch;
    float y = 0.f;
    for (int k = 0; k < 3; ++k) { const int tt = t - 2 + k; if (tt < 0) continue; const long o = base - (long)(2 - k) * 512;
        y += p.conv_w[k * 512 + ch] * (bf2f(p.reg5[3][o]) * bf2f(p.reg5[1][o])); }
    const float v = bf2f(p.reg5[2][base]) * y * siluf(bf2f(p.reg5[4][base]));
    p.mixed[((long)b * S + t) * 1024 + 512 + ch] = f2bf(v);
}
HD void final_norm_body(const Params& p, long row) {
    float* yr = p.out + row * DM; float ss = 0.f;
    for (int k = 0; k < DM; ++k) ss += yr[k] * yr[k];
    const float r = 1.0f / sqrtf(ss / DM + 1e-6f);
    for (int k = 0; k < DM; ++k) yr[k] = yr[k] * r * p.fnw[k];
}

static inline size_t carve(Params& p, char* base) {
    size_t off = 0; auto take = [&](size_t bytes) { char* r = base ? base + off : nullptr; off += (bytes + 255) & ~(size_t)255; return r; };
    p.bar = (unsigned*)take(16384);
    p.wt_in = (bf16*)take((size_t)NP * DM * 2); p.wt_out = (bf16*)take((size_t)DM * DM * 2);
    for (int w = 0; w < 2; ++w) p.w1t[w] = (bf16*)take(128 * 2048 * 2);
    for (int w = 0; w < 2; ++w) p.w2t[w] = (bf16*)take(64 * 128 * 2);
    for (int w = 0; w < 2; ++w) p.peb[w] = (float*)take(128 * 4);
    p.bias_tab = (float*)take(129 * 8 * 4);
    p.xb = (bf16*)take((size_t)ROWS * DM * 2); p.attn_acc = (float*)p.xb;
    p.rstd = (float*)take((size_t)ROWS * 4);
    p.q = (bf16*)take((size_t)NB * NH * S * 64 * 2);
    for (int j = 0; j < 6; ++j) p.kv[j] = (bf16*)take((size_t)NB * NG * S * 64 * 2);
    for (int j = 0; j < 5; ++j) p.reg5[j] = (bf16*)take((size_t)ROWS * 512 * 2);
    p.gates = (float*)take((size_t)ROWS * 24 * 4);
    p.hid = (float*)take((size_t)2 * NB * NG * NCP * 128 * 4);
    for (int w = 0; w < 2; ++w) p.kcvc[w] = (bf16*)take((size_t)NB * NG * NCP * 64 * 2);
    p.imp = (float*)take((size_t)NB * NG * S * 128 * 4);
    p.idx = (int*)take((size_t)NB * NG * S * 16 * 4);
    p.mixed = (bf16*)take((size_t)ROWS * 1024 * 2);
    return off;
}

#ifndef HOST_EMU
#define LAS __attribute__((address_space(3)))
#define XB_TMO      128
#define XB_XCNT(j)  (256  + 64 * (j))
#define XB_XSUB(j)  (1280 + 64 * (j))
#define XB_XGEN(j)  (2304 + 64 * (j))
#define XB_TOP      3328
#define XB_TOPGEN   3392
#define XCD_BAR_WORDS 3456
#define XB_SPIN_CAP (1u << 22)
__device__ __forceinline__ unsigned xb_ld(unsigned* p)              { return __hip_atomic_load(p, __ATOMIC_RELAXED, __HIP_MEMORY_SCOPE_AGENT); }
__device__ __forceinline__ unsigned xb_add(unsigned* p, unsigned v) { return __hip_atomic_fetch_add(p, v, __ATOMIC_RELAXED, __HIP_MEMORY_SCOPE_AGENT); }
__device__ __forceinline__ unsigned xb_xcc_id() { return (unsigned)__builtin_amdgcn_s_getreg((3 << 11) | 20) & 0xFu; }
#define XB_SPIN(cond, bar) do { unsigned _sp = 0; while (cond) { __builtin_amdgcn_s_sleep(1); \
    if ((++_sp & 255u) == 0u) { if (xb_ld(&(bar)[XB_TMO])) break; if (_sp > XB_SPIN_CAP) { atomicAdd(&(bar)[XB_TMO], 1u); break; } } } } while (0)
struct XcdBarrier { unsigned* bar; unsigned x; volatile LAS unsigned* st; };
__device__ __forceinline__ XcdBarrier xcd_barrier_post(unsigned* bar, volatile LAS unsigned* st) {
    XcdBarrier b; b.bar = bar; b.x = xb_xcc_id(); b.st = st;
    if (threadIdx.x == 0) (void)xb_add(&bar[XB_XCNT(b.x)], 1u);
    return b;
}
__device__ __forceinline__ void xcd_barrier_complete(unsigned* bar, unsigned x, unsigned& nloc, unsigned& nx) {
    const unsigned G = gridDim.x * gridDim.y * gridDim.z;
    unsigned sum, cnt, mine, sp = 0u;
    for (;;) {
        sum = 0u; cnt = 0u; mine = 0u;
#pragma unroll
        for (unsigned j = 0; j < 16; ++j) { const unsigned c = xb_ld(&bar[XB_XCNT(j)]); sum += c; cnt += (c > 0u) ? 1u : 0u; mine = (j == x) ? c : mine; }
        if (sum == G) break;
        __builtin_amdgcn_s_sleep(1);
        if ((++sp & 255u) == 0u) { if (xb_ld(&bar[XB_TMO])) break; if (sp > XB_SPIN_CAP) { atomicAdd(&bar[XB_TMO], 1u); break; } }
    }
    nloc = mine > 0u ? mine : 1u; nx = cnt > 0u ? cnt : 1u;
}
__device__ __forceinline__ void xcd_barrier(const XcdBarrier& b) {
    asm volatile("s_waitcnt vmcnt(0)" ::: "memory");
    __syncthreads();
    if (threadIdx.x == 0) {
        unsigned* bar = b.bar;
        __builtin_amdgcn_s_waitcnt(0);
        unsigned nloc = b.st[0], nx = b.st[1];
        if (nloc == 0u) { xcd_barrier_complete(bar, b.x, nloc, nx); b.st[0] = nloc; b.st[1] = nx; }
        const unsigned old = xb_add(&bar[XB_XSUB(b.x)], 1u);
        const unsigned gen = old / nloc;
        if (old + 1u == (gen + 1u) * nloc) {
            __builtin_amdgcn_fence(__ATOMIC_RELEASE, "agent");
            asm volatile("s_waitcnt vmcnt(0)" ::: "memory");
            const unsigned og = xb_add(&bar[XB_TOP], 1u);
            const unsigned tg = og / nx;
            if (og + 1u == (tg + 1u) * nx) xb_add(&bar[XB_TOPGEN], 1u);
            else XB_SPIN(xb_ld(&bar[XB_TOPGEN]) == tg, bar);
            __builtin_amdgcn_fence(__ATOMIC_ACQUIRE, "agent");
            xb_add(&bar[XB_XGEN(b.x)], 1u);
            asm volatile("s_waitcnt vmcnt(0)" ::: "memory");
        } else {
            XB_SPIN(xb_ld(&bar[XB_XGEN(b.x)]) == gen, bar);
            __builtin_amdgcn_fence(__ATOMIC_ACQUIRE, "agent");
            asm volatile("s_waitcnt vmcnt(0)" ::: "memory");
        }
    }
    __syncthreads();
}

typedef short bf16x8 __attribute__((ext_vector_type(8)));
typedef float f32x4 __attribute__((ext_vector_type(4)));
constexpr int NTHREADS = 256, NWAVES = 4, LDS_BYTES = 147456;
template <int MODE> __device__ __forceinline__ void gemm_tiles(const Params& p, const bf16* A, const bf16* Bt, int M, int N, int K) {
    const int wave = threadIdx.x >> 6, lane = threadIdx.x & 63, c = lane & 15, g = lane >> 4;
    const int tilesN = N / 64; const long ntiles = (long)(M / 64) * tilesN;
    for (long tile = (long)blockIdx.x * NWAVES + wave; tile < ntiles; tile += (long)gridDim.x * NWAVES) {
        const int m0 = (int)(tile / tilesN) * 64, n0 = (int)(tile % tilesN) * 64;
        f32x4 acc[4][4];
#pragma unroll
        for (int i = 0; i < 4; ++i)
#pragma unroll
            for (int j = 0; j < 4; ++j) acc[i][j] = (f32x4){0.f, 0.f, 0.f, 0.f};
        for (int k0 = 0; k0 < K; k0 += 32) {
            bf16x8 a[4], bb[4];
#pragma unroll
            for (int i = 0; i < 4; ++i) a[i] = *(const bf16x8*)(A + (long)(m0 + 16 * i + c) * K + k0 + 8 * g);
#pragma unroll
            for (int j = 0; j < 4; ++j) bb[j] = *(const bf16x8*)(Bt + (long)(n0 + 16 * j + c) * K + k0 + 8 * g);
#pragma unroll
            for (int i = 0; i < 4; ++i)
#pragma unroll
                for (int j = 0; j < 4; ++j) acc[i][j] = __builtin_amdgcn_mfma_f32_16x16x32_bf16(a[i], bb[j], acc[i][j], 0, 0, 0);
        }
#pragma unroll
        for (int i = 0; i < 4; ++i)
#pragma unroll
            for (int j = 0; j < 4; ++j)
#pragma unroll
                for (int r = 0; r < 4; ++r) {
                    const int row = m0 + 16 * i + 4 * g + r, col = n0 + 16 * j + c; const float v = acc[i][j][r];
                    if (MODE == 0) store_proj(p, row, col, v * p.rstd[row]);
                    else p.out[(long)row * DM + col] = p.x[(long)row * DM + col] + v;
                }
    }
}

__global__ void __launch_bounds__(NTHREADS, 1) mega_fwd(Params p) {
    extern __shared__ __attribute__((aligned(16))) unsigned char lds[];
    volatile LAS unsigned* st = (volatile LAS unsigned*)((LAS unsigned char*)lds + LDS_BYTES - 64);
    if (threadIdx.x < 16) st[threadIdx.x] = 0u;
    __syncthreads();
    const XcdBarrier bar = xcd_barrier_post(p.bar, st);
    const long T = (long)gridDim.x * NTHREADS, t0 = (long)blockIdx.x * NTHREADS + threadIdx.x;
#define SWEEP(name, n) for (long g_ = t0; g_ < (long)(n); g_ += T) name##_body(p, g_)
    SWEEP(prep_wtin, (long)NP * DM); SWEEP(prep_wtout, (long)DM * DM); SWEEP(prep_w1t, 2L * 128 * 2048); SWEEP(prep_w2t, 2L * 64 * 128);
    SWEEP(prep_peb, 256); SWEEP(prep_bias, 129 * 8); SWEEP(prep_x, ROWS);
    xcd_barrier(bar);
    gemm_tiles<0>(p, p.xb, p.wt_in, ROWS, NP, DM);
    xcd_barrier(bar);
    SWEEP(compress1, 2L * NB * NG * NCMP * 128); SWEEP(conv, (long)NB * S * 512);
    xcd_barrier(bar);
    SWEEP(compress2, 2L * NB * NG * NCMP * 64);
    xcd_barrier(bar);
    SWEEP(cmp, (long)NB * NG * S);
    xcd_barrier(bar);
    SWEEP(slcwin, (long)NB * NH * S);
    xcd_barrier(bar);
    gemm_tiles<1>(p, p.mixed, p.wt_out, ROWS, DM, DM);
    xcd_barrier(bar);
    SWEEP(final_norm, ROWS);
}

extern "C" void kernel_launch(void* const* d_in, const int* in_sizes, int n_in, void* d_out, int out_size, void* d_ws, size_t ws_size, hipStream_t stream) {
    static int grid = 0;
    if (grid == 0) {
        int dev = 0, cus = 0, per_cu = 0;
        if (hipGetDevice(&dev) != hipSuccess || hipDeviceGetAttribute(&cus, hipDeviceAttributeMultiprocessorCount, dev) != hipSuccess) { fprintf(stderr, "kernel_launch: device query failed\n"); grid = -1; return; }
        if (hipFuncSetAttribute((const void*)mega_fwd, hipFuncAttributeMaxDynamicSharedMemorySize, LDS_BYTES) != hipSuccess) { fprintf(stderr, "kernel_launch: hipFuncSetAttribute failed\n"); grid = -1; return; }
        if (hipOccupancyMaxActiveBlocksPerMultiprocessor(&per_cu, (const void*)mega_fwd, NTHREADS, LDS_BYTES) != hipSuccess || per_cu < 1) { fprintf(stderr, "kernel_launch: occupancy query says %d blocks per CU\n", per_cu); grid = -1; return; }
        (void)hipGetLastError();
        grid = cus;
    }
    if (grid < 0) return;
    Params p; memset(&p, 0, sizeof(p));
    const float** ins[13] = {&p.x, &p.norm_w, &p.w_in, &p.w_ck1, &p.w_ck2, &p.pe_k, &p.w_cv1, &p.w_cv2, &p.pe_v, &p.conv_w, &p.w_out, &p.rel_bias, &p.fnw};
    for (int i = 0; i < 13; ++i) *ins[i] = (const float*)d_in[i];
    p.out = (float*)d_out;
    const size_t need = carve(p, (char*)d_ws);
    if (need > ws_size) { fprintf(stderr, "workspace too small: need %zu have %zu\n", need, ws_size); return; }
    if (hipMemsetAsync(p.bar, 0, 16384, stream) != hipSuccess) { fprintf(stderr, "kernel_launch: memset failed\n"); return; }
    hipLaunchKernelGGL(mega_fwd, dim3(grid), dim3(NTHREADS), LDS_BYTES, stream, p);
}
#endif
```

```cpp
#ifndef HOST_EMU
#include <hip/hip_runtime.h>
#include <cstdio>
#include <cstdint>
#include <cstring>
#define HD __host__ __device__ __forceinline__
#else
#include <cmath>
#include <cstdio>
#include <cstdint>
#include <cstring>
#define HD static inline
#endif

#ifndef SEQ
#define SEQ 8192
#endif
typedef unsigned short bf16;
constexpr int NB = 2, S = SEQ, DM = 1024, NH = 8, HDIM = 64, NG = 2, NR = 4, DATT = 512, DCONV = 512;
constexpr int INCOLS = 3864, NP = 4096, NCMP = S / 16 - 1, NCP = S / 16, NSEL = S / 64, KTOP = (NSEL < 16 ? NSEL : 16);
constexpr int WIN = 512, ROWS = NB * S;
constexpr long KVSZ = (long)NB * NG * S * 64, R5SZ = (long)ROWS * 512;
constexpr float QSCALE = 0.125f * 1.4426950408889634f, INV_LOG2E = 0.6931471805599453f;

HD float bf2f(bf16 v) { union { unsigned u; float f; } c; c.u = ((unsigned)v) << 16; return c.f; }
HD bf16 f2bf(float f) { union { unsigned u; float f; } c; c.f = f; unsigned u = c.u; unsigned r = u + 0x7FFFu + ((u >> 16) & 1u); return (bf16)(r >> 16); }
HD float siluf(float v) { return v / (1.f + expf(-v)); }
HD float sigmf(float v) { return 1.f / (1.f + expf(-v)); }

struct Params {
    const float *x, *norm_w, *w_in, *w_ck1, *w_ck2, *pe_k, *w_cv1, *w_cv2, *pe_v, *conv_w, *w_out, *rel_bias, *fnw;
    float* out;
    unsigned* bar;
    bf16 *wt_in, *wt_out, *w1t[2], *w2t[2];
    float *peb[2], *bias_tab;
    bf16* xb; float* rstd;
    bf16 *q, *kv[6], *reg5[5];
    float* gates;
    float* hid;
    bf16* kcvc[2];
    float* imp; int* idx; float* attn_acc; bf16* mixed; float* rowss;
    bf16 *vts, *vtw, *vct; unsigned* ctr;
};

HD int t5_bucket(int d) {
    if (d >= 128) return 31;
    const unsigned long long lo = 0x81041088929fffeull, hi = 0x2000800802008ull;
    if (d < 64) return __builtin_popcountll(lo & ((2ull << d) - 1ull));
    return __builtin_popcountll(lo) + __builtin_popcountll(hi & ((2ull << (d - 64)) - 1ull));
}
HD int src_col(int n) { return n < 1280 ? n : (n < 3840 ? n + 24 : (n < 3864 ? 1280 + (n - 3840) : -1)); }
HD void prep_wtin_body(const Params& p, long gid) {
    const int n = (int)(gid / DM), k = (int)(gid % DM); const int c = src_col(n);
    p.wt_in[gid] = c < 0 ? (bf16)0 : f2bf(p.norm_w[k] * p.w_in[(long)k * INCOLS + c]);
}
HD void prep_wtout_body(const Params& p, long gid) {
    const int n = (int)(gid / DM), k = (int)(gid % DM);
    p.wt_out[gid] = f2bf(p.w_out[(long)k * DM + n]);
}
HD void prep_w1t_body(const Params& p, long gid) {
    const int w = (int)(gid / (128 * 2048)), r = (int)(gid % (128 * 2048)), h = r / 2048, jd = r % 2048;
    const float* w1 = w ? p.w_cv1 : p.w_ck1;
    p.w1t[w][r] = f2bf(w1[(long)jd * 128 + h]);
}
HD void prep_w2t_body(const Params& p, long gid) {
    const int w = (int)(gid / (64 * 128)), r = (int)(gid % (64 * 128)), d = r / 128, h = r % 128;
    const float* w2 = w ? p.w_cv2 : p.w_ck2;
    p.w2t[w][r] = f2bf(w2[h * 64 + d]);
}
HD void prep_peb_body(const Params& p, long gid) {
    const int w = (int)(gid / 128), h = (int)(gid % 128);
    const float* w1 = w ? p.w_cv1 : p.w_ck1; const float* pe = w ? p.pe_v : p.pe_k;
    float a = 0.f; for (int jd = 0; jd < 2048; ++jd) a += pe[jd] * w1[(long)jd * 128 + h];
    p.peb[w][h] = a;
}
HD void prep_bias_body(const Params& p, long gid) {
    const int d = (int)(gid / 8), h = (int)(gid % 8); const int bk = t5_bucket(d);
    p.bias_tab[gid] = p.rel_bias[bk * 8 + h];
}
HD void prep_x_body(const Params& p, long row) {
    const float* xr = p.x + row * DM; float ss = 0.f;
    for (int k = 0; k < DM; ++k) { const float v = xr[k]; ss += v * v; p.xb[row * DM + k] = f2bf(v); }
    p.rstd[row] = 1.0f / sqrtf(ss / DM + 1e-6f);
}
HD void store_proj(const Params& p, int row, int n, float v) {
    const int b = row / S, s = row % S;
    if (n < 512) { const int h = n >> 6, d = n & 63; p.q[(((long)b * NH + h) * S + s) * 64 + d] = f2bf(v * QSCALE); }
    else if (n < 1280) { const int j = (n - 512) >> 7, g = ((n - 512) >> 6) & 1, d = n & 63; p.kv[j][(((long)b * NG + g) * S + s) * 64 + d] = f2bf(v); }
    else if (n < 3840) { const int r = (n - 1280) >> 9, c = (n - 1280) & 511; p.reg5[r][((long)b * S + s) * 512 + c] = f2bf(v); }
    else if (n < 3864) { p.gates[((long)b * S + s) * 24 + (n - 3840)] = sigmf(v); }
}
HD void compress1_body(const Params& p, long gid) {
    const int h = (int)(gid % 128); long r = gid / 128; const int c = (int)(r % NCMP); r /= NCMP; const int g = (int)(r % NG); r /= NG; const int b = (int)(r % NB); const int w = (int)(r / NB);
    const bf16* src = p.kv[w] + (((long)b * NG + g) * S + 16 * c) * 64;
    const bf16* wr = p.w1t[w] + (long)h * 2048;
    float a = p.peb[w][h];
    for (int jd = 0; jd < 2048; ++jd) a += bf2f(src[jd]) * bf2f(wr[jd]);
    p.hid[((((long)w * NB + b) * NG + g) * NCP + c) * 128 + h] = a;
}
HD void compress2_body(const Params& p, long gid) {
    const int d = (int)(gid % 64); long r = gid / 64; const int c = (int)(r % NCMP); r /= NCMP; const int g = (int)(r % NG); r /= NG; const int b = (int)(r % NB); const int w = (int)(r / NB);
    const float* hp = p.hid + ((((long)w * NB + b) * NG + g) * NCP + c) * 128;
    const bf16* wr = p.w2t[w] + d * 128;
    float a = 0.f;
    for (int h = 0; h < 128; ++h) a += bf2f(f2bf(siluf(hp[h]))) * bf2f(wr[h]);
    p.kcvc[w][(((long)b * NG + g) * NCP + c) * 64 + d] = f2bf(a);
}
HD float dot64(const bf16* q, const bf16* k) { float a = 0.f;
#pragma unroll 8
    for (int d = 0; d < 64; ++d) a += bf2f(q[d]) * bf2f(k[d]);
    return a; }

HD void cmp_body(const Params& p, long gid) {
    const int t = (int)(gid % S); const int g = (int)((gid / S) % NG); const int b = (int)(gid / ((long)S * NG));
    const int nv = t >= 31 ? (t - 31) / 16 + 1 : 0;
    float* imp = p.imp + gid * 128;
    for (int n = 0; n < 128; ++n) imp[n] = 0.f;
    const bf16* kc = p.kcvc[0] + ((long)b * NG + g) * NCP * 64;
    const bf16* vc = p.kcvc[1] + ((long)b * NG + g) * NCP * 64;
    for (int r = 0; r < NR; ++r) {
        const int h = g * NR + r;
        const bf16* qp = p.q + (((long)b * NH + h) * S + t) * 64;
        const bf16* q = qp; float o[64];
#pragma unroll
        for (int d = 0; d < 64; ++d) o[d] = 0.f;
        float m = -1e30f;
        for (int c = 0; c < nv; ++c) { const int dist = t - (16 * c + 31); const float s = dot64(q, kc + c * 64) * INV_LOG2E + p.bias_tab[(dist < 128 ? dist : 128) * 8 + h]; m = fmaxf(m, s); }
        float l = 0.f;
        for (int c = 0; c < nv; ++c) { const int dist = t - (16 * c + 31); const float s = dot64(q, kc + c * 64) * INV_LOG2E + p.bias_tab[(dist < 128 ? dist : 128) * 8 + h]; l += expf(s - m); }
        const float inv = 1.f / fmaxf(l, 1e-30f);
        for (int c = 0; c < nv; ++c) {
            const int dist = t - (16 * c + 31); const float s = dot64(q, kc + c * 64) * INV_LOG2E + p.bias_tab[(dist < 128 ? dist : 128) * 8 + h];
            const float pr = expf(s - m) * inv;
#pragma unroll
            for (int d = 0; d < 64; ++d) o[d] += pr * bf2f(vc[c * 64 + d]);
            imp[c >> 2] += pr; if ((c & 3) == 3) imp[(c >> 2) + 1] += pr;
        }
        const float g0 = p.gates[((long)b * S + t) * 24 + 0 * 8 + h];
        float* ao = p.attn_acc + ((long)b * S + t) * 512 + h * 64;
#pragma unroll
        for (int d = 0; d < 64; ++d) ao[d] = g0 * o[d];
    }
    const int blk = t >> 6;
    for (int n = 0; n < NSEL; ++n) { const bool forced = (n == 0) || (n == blk) || (n == blk - 1); imp[n] = forced ? 1e3f : (n <= blk ? imp[n] : -1.0f); }
    int* idx = p.idx + gid * 16;
    for (int k = 0; k < KTOP; ++k) {
        float best = -3e38f; int bi = 0;
        for (int n = 0; n < NSEL; ++n) { const float v = imp[n]; if (v > best) { best = v; bi = n; } }
        idx[k] = bi; imp[bi] = -3.4e38f;
    }
}
HD void slcwin_body(const Params& p, long gid) {
    const int t = (int)(gid % S); const int h = (int)((gid / S) % NH); const int b = (int)(gid / ((long)S * NH)); const int g = h / NR;
    const bf16* qp = p.q + (((long)b * NH + h) * S + t) * 64;
    const bf16* q = qp; float o[64];
#pragma unroll
    for (int d = 0; d < 64; ++d) o[d] = 0.f;
    const long kvoff = ((long)b * NG + g) * S * 64;
    float* ai = p.attn_acc + ((long)b * S + t) * 512 + h * 64;
    {
        const bf16* K = p.kv[2] + kvoff; const bf16* V = p.kv[3] + kvoff;
        const int* idx = p.idx + (((long)b * NG + g) * S + t) * 16;
        float m = -1e30f, l = 0.f;
        for (int k = 0; k < KTOP; ++k) {
            const int n = idx[k];
            for (int j = 0; j < 64; ++j) {
                const int pos = n * 64 + j, dist = t - pos; if (dist < 0) continue;
                const float s = dot64(q, K + (long)pos * 64) * INV_LOG2E + p.bias_tab[(dist < 128 ? dist : 128) * 8 + h];
                if (s > m) { const float f = expf(m - s); l *= f;
#pragma unroll
                    for (int d = 0; d < 64; ++d) o[d] *= f;
                    m = s; }
                const float pr = expf(s - m); l += pr;
#pragma unroll
                for (int d = 0; d < 64; ++d) o[d] += pr * bf2f(V[(long)pos * 64 + d]);
            }
        }
        const float g1 = p.gates[((long)b * S + t) * 24 + 1 * 8 + h] / fmaxf(l, 1e-30f);
#pragma unroll
        for (int d = 0; d < 64; ++d) { ai[d] += g1 * o[d]; o[d] = 0.f; }
    }
    {
        const bf16* K = p.kv[4] + kvoff; const bf16* V = p.kv[5] + kvoff;
        float m = -1e30f, l = 0.f;
        const int lo = t - (WIN - 1) > 0 ? t - (WIN - 1) : 0;
        for (int pos = lo; pos <= t; ++pos) {
            const int dist = t - pos;
            const float s = dot64(q, K + (long)pos * 64) * INV_LOG2E + p.bias_tab[(dist < 128 ? dist : 128) * 8 + h];
            if (s > m) { const float f = expf(m - s); l *= f;
#pragma unroll
                for (int d = 0; d < 64; ++d) o[d] *= f;
                m = s; }
            const float pr = expf(s - m); l += pr;
#pragma unroll
            for (int d = 0; d < 64; ++d) o[d] += pr * bf2f(V[(long)pos * 64 + d]);
        }
        const float g2 = p.gates[((long)b * S + t) * 24 + 2 * 8 + h] / fmaxf(l, 1e-30f);
        const bf16* z = p.reg5[0] + ((long)b * S + t) * 512 + h * 64;
        bf16* mo = p.mixed + ((long)b * S + t) * 1024 + h * 64;
#pragma unroll
        for (int d = 0; d < 64; ++d) mo[d] = f2bf((ai[d] + g2 * o[d]) * siluf(bf2f(z[d])));
    }
}
HD void conv_body(const Params& p, long gid) {
    const int ch = (int)(gid % 512); const int t = (int)((gid / 512) % S); const int b = (int)(gid / (512L * S));
    const long base = ((long)b * S + t) * 512 + ch;
    float y = 0.f;
    for (int k = 0; k < 3; ++k) { const int tt = t - 2 + k; if (tt < 0) continue; const long o = base - (long)(2 - k) * 512;
        y += p.conv_w[k * 512 + ch] * (bf2f(p.reg5[3][o]) * bf2f(p.reg5[1][o])); }
    const float v = bf2f(p.reg5[2][base]) * y * siluf(bf2f(p.reg5[4][base]));
    p.mixed[((long)b * S + t) * 1024 + 512 + ch] = f2bf(v);
}
HD void final_norm_body(const Params& p, long row) {
    float* yr = p.out + row * DM; float ss = 0.f;
    for (int k = 0; k < DM; ++k) ss += yr[k] * yr[k];
    const float r = 1.0f / sqrtf(ss / DM + 1e-6f);
    for (int k = 0; k < DM; ++k) yr[k] = yr[k] * r * p.fnw[k];
}

static inline size_t carve(Params& p, char* base) {
    size_t off = 0; auto take = [&](size_t bytes) { char* r = base ? base + off : nullptr; off += (bytes + 255) & ~(size_t)255; return r; };
    p.bar = (unsigned*)take(16384);
    p.wt_in = (bf16*)take((size_t)NP * DM * 2); p.wt_out = (bf16*)take((size_t)DM * DM * 2);
    for (int w = 0; w < 2; ++w) p.w1t[w] = (bf16*)take(128 * 2048 * 2);
    for (int w = 0; w < 2; ++w) p.w2t[w] = (bf16*)take(64 * 128 * 2);
    for (int w = 0; w < 2; ++w) p.peb[w] = (float*)take(128 * 4);
    p.bias_tab = (float*)take(129 * 8 * 4);
    p.xb = (bf16*)take((size_t)ROWS * DM * 2); p.attn_acc = (float*)p.xb;
    p.rstd = (float*)take((size_t)ROWS * 4);
    p.q = (bf16*)take((size_t)NB * NH * S * 64 * 2);
    for (int j = 0; j < 6; ++j) p.kv[j] = (bf16*)take((size_t)NB * NG * S * 64 * 2);
    for (int j = 0; j < 5; ++j) p.reg5[j] = (bf16*)take((size_t)ROWS * 512 * 2);
    p.gates = (float*)take((size_t)ROWS * 24 * 4);
    p.hid = (float*)take((size_t)2 * NB * NG * NCP * 128 * 4);
    for (int w = 0; w < 2; ++w) p.kcvc[w] = (bf16*)take((size_t)NB * NG * NCP * 64 * 2);
    p.imp = (float*)take((size_t)NB * NG * S * 128 * 4);
    p.idx = (int*)take((size_t)NB * NG * S * 16 * 4);
    p.mixed = (bf16*)take((size_t)ROWS * 1024 * 2);
    p.rowss = (float*)take((size_t)ROWS * 16 * 4);
    p.vts = (bf16*)take((size_t)KVSZ * 2); p.vtw = (bf16*)take((size_t)KVSZ * 2); p.vct = (bf16*)take((size_t)NB * NG * 64 * NCP * 2);
    p.ctr = p.bar + 3600;
    return off;
}

#ifndef HOST_EMU
#define LAS __attribute__((address_space(3)))
#define XB_TMO      128
#define XB_XCNT(j)  (256  + 64 * (j))
#define XB_XSUB(j)  (1280 + 64 * (j))
#define XB_XGEN(j)  (2304 + 64 * (j))
#define XB_TOP      3328
#define XB_TOPGEN   3392
#define XCD_BAR_WORDS 3456
#define XB_SPIN_CAP (1u << 22)
__device__ __forceinline__ unsigned xb_ld(unsigned* p)              { return __hip_atomic_load(p, __ATOMIC_RELAXED, __HIP_MEMORY_SCOPE_AGENT); }
__device__ __forceinline__ unsigned xb_add(unsigned* p, unsigned v) { return __hip_atomic_fetch_add(p, v, __ATOMIC_RELAXED, __HIP_MEMORY_SCOPE_AGENT); }
__device__ __forceinline__ unsigned xb_xcc_id() { return (unsigned)__builtin_amdgcn_s_getreg((3 << 11) | 20) & 0xFu; }
#define XB_SPIN(cond, bar) do { unsigned _sp = 0; while (cond) { __builtin_amdgcn_s_sleep(1); \
    if ((++_sp & 255u) == 0u) { if (xb_ld(&(bar)[XB_TMO])) break; if (_sp > XB_SPIN_CAP) { atomicAdd(&(bar)[XB_TMO], 1u); break; } } } } while (0)
struct XcdBarrier { unsigned* bar; unsigned x; volatile LAS unsigned* st; };
__device__ __forceinline__ XcdBarrier xcd_barrier_post(unsigned* bar, volatile LAS unsigned* st) {
    XcdBarrier b; b.bar = bar; b.x = xb_xcc_id(); b.st = st;
    if (threadIdx.x == 0) (void)xb_add(&bar[XB_XCNT(b.x)], 1u);
    return b;
}
__device__ __forceinline__ void xcd_barrier_complete(unsigned* bar, unsigned x, unsigned& nloc, unsigned& nx) {
    const unsigned G = gridDim.x * gridDim.y * gridDim.z;
    unsigned sum, cnt, mine, sp = 0u;
    for (;;) {
        sum = 0u; cnt = 0u; mine = 0u;
#pragma unroll
        for (unsigned j = 0; j < 16; ++j) { const unsigned c = xb_ld(&bar[XB_XCNT(j)]); sum += c; cnt += (c > 0u) ? 1u : 0u; mine = (j == x) ? c : mine; }
        if (sum == G) break;
        __builtin_amdgcn_s_sleep(1);
        if ((++sp & 255u) == 0u) { if (xb_ld(&bar[XB_TMO])) break; if (sp > XB_SPIN_CAP) { atomicAdd(&bar[XB_TMO], 1u); break; } }
    }
    nloc = mine > 0u ? mine : 1u; nx = cnt > 0u ? cnt : 1u;
}
__device__ __forceinline__ void xcd_barrier(const XcdBarrier& b) {
    asm volatile("s_waitcnt vmcnt(0)" ::: "memory");
    __syncthreads();
    if (threadIdx.x == 0) {
        unsigned* bar = b.bar;
        __builtin_amdgcn_s_waitcnt(0);
        unsigned nloc = b.st[0], nx = b.st[1];
        if (nloc == 0u) { xcd_barrier_complete(bar, b.x, nloc, nx); b.st[0] = nloc; b.st[1] = nx; }
        const unsigned old = xb_add(&bar[XB_XSUB(b.x)], 1u);
        const unsigned gen = old / nloc;
        if (old + 1u == (gen + 1u) * nloc) {
            __builtin_amdgcn_fence(__ATOMIC_RELEASE, "agent");
            asm volatile("s_waitcnt vmcnt(0)" ::: "memory");
            const unsigned og = xb_add(&bar[XB_TOP], 1u);
            const unsigned tg = og / nx;
            if (og + 1u == (tg + 1u) * nx) xb_add(&bar[XB_TOPGEN], 1u);
            else XB_SPIN(xb_ld(&bar[XB_TOPGEN]) == tg, bar);
            __builtin_amdgcn_fence(__ATOMIC_ACQUIRE, "agent");
            xb_add(&bar[XB_XGEN(b.x)], 1u);
            asm volatile("s_waitcnt vmcnt(0)" ::: "memory");
        } else {
            XB_SPIN(xb_ld(&bar[XB_XGEN(b.x)]) == gen, bar);
            __builtin_amdgcn_fence(__ATOMIC_ACQUIRE, "agent");
            asm volatile("s_waitcnt vmcnt(0)" ::: "memory");
        }
    }
    __syncthreads();
}

namespace pg8 {
#define PG8_LAS __attribute__((address_space(3)))
typedef unsigned short bf16_t;
typedef short bf16x8 __attribute__((ext_vector_type(8)));
typedef float f32x4 __attribute__((ext_vector_type(4)));
typedef unsigned u32x4 __attribute__((ext_vector_type(4)));
constexpr int BM = 256, BK = 64, HALF = 128, HTB = HALF * BK * 2  , STAGE_BYTES = 8 * HTB, NXCD = 8, WGM = 8;

__host__ __device__ __forceinline__ int lds_byte(int r, int c) { const int st = (r >> 4) * 2 + (c >> 5), rr = r & 15, cc = c & 31, ob = rr * 64 + cc * 2; return st * 1024 + (ob ^ (((ob >> 9) & 1) << 5)); }
__host__ __device__ __forceinline__ void stage_rc(int b, int& R, int& C) { const int st = b / 1024, sb = b % 1024, swz = sb ^ (((sb >> 9) & 1) << 5); R = (st >> 1) * 16 + swz / 64; C = (st & 1) * 32 + (swz % 64) / 2; }
__host__ __device__ __forceinline__ int perm32(int rho) { const int n = rho >> 4, i = rho & 15; return 8 * (i >> 2) + 4 * n + (i & 3); }

struct Unit { int pm, pn; };
struct Gemm { const bf16_t* A; const bf16_t* Bt; int M, N, K; };

struct StaticOrder {
    int nM, nN, nwg, G, c;
    __host__ __device__ void init(int M, int N, int G_, int c_) { nM = M / BM; nN = N / BM; nwg = nM * nN; G = G_; c = c_; }
    __host__ __device__ bool next(int i, Unit& u) const {
        const long L = (long)i * G + c; if (L >= nwg) return false;
        int wgid = (int)L; { const int q = nwg / NXCD, r = nwg % NXCD, xcd = wgid % NXCD, off = wgid / NXCD; wgid = (xcd < r ? xcd * (q + 1) : r * (q + 1) + (xcd - r) * q) + off; }
        const int nig = WGM * nN, gid = wgid / nig, fm = gid * WGM, gsz = (nM - fm) < WGM ? (nM - fm) : WGM;
        u.pm = fm + ((wgid % nig) % gsz); u.pn = (wgid % nig) / gsz; return true;
    }
    __device__ __forceinline__ void a_ready(const Unit&) const {}
    __device__ __forceinline__ void done(const Unit&) const {}
};
__device__ __forceinline__ unsigned cvt_pk_bf16(float lo, float hi) { unsigned r; asm volatile("v_cvt_pk_bf16_f32 %0, %1, %2" : "=v"(r) : "v"(lo), "v"(hi)); return r; }
template <class Epi, class Sched, bool ALIGN_EPI = false, bool SP2 = false>
__device__ __forceinline__ void gemm_phase(PG8_LAS unsigned char* lds, const Gemm g, const Sched& S, const Epi& E) {
    const int tid = threadIdx.x, wid = __builtin_amdgcn_readfirstlane(tid >> 6), lane = tid & 63, wr = wid >> 2, wc = wid & 3, fr = lane & 15, fq = lane >> 4;
    const int K = g.K, nt = K / BK;
    unsigned voffA[2], voffB[2];
#pragma unroll
    for (int i = 0; i < 2; ++i) { int R, C; stage_rc(tid * 16 + i * 8192, R, C); const int Rb = Epi::PERM ? ((R & ~31) + perm32(R & 31)) : R;
        voffA[i] = (unsigned)(R * K + C) * 2u; voffB[i] = (unsigned)(Rb * K + C) * 2u; }
    const size_t kstep = (size_t)(BK * 2);
    const size_t hstep = (size_t)HALF * K * 2;
    const size_t tstep = 2 * hstep;
    const unsigned ldsw = (unsigned)wid * 1024u;
    const int aoff = lds_byte(wr * 64 + fr, fq * 8), boff = lds_byte(wc * 32 + fr, fq * 8);
#define PG8_SA(b, h) (((b) * 2 + (h)) * HTB)
#define PG8_SB(b, h) ((4 + (b) * 2 + (h)) * HTB)
#define PG8_STAGE(bufoff, gbase, voff) do { _Pragma("unroll") for (int _i = 0; _i < 2; ++_i) \
        __builtin_amdgcn_global_load_lds((const unsigned*)((const char*)(gbase) + (voff)[_i]), (PG8_LAS unsigned*)(lds + (bufoff) + ldsw + _i * 8192), 16, 0, 0); } while (0)
#define PG8_LDA(dst, b, h) do { _Pragma("unroll") for (int m = 0; m < 4; ++m) _Pragma("unroll") for (int k = 0; k < 2; ++k) dst[m][k] = *(const PG8_LAS bf16x8*)(lds + PG8_SA(b, h) + aoff + m * 2048 + k * 1024); } while (0)
#define PG8_LDB(dst, b, h) do { _Pragma("unroll") for (int n = 0; n < 2; ++n) _Pragma("unroll") for (int k = 0; k < 2; ++k) dst[n][k] = *(const PG8_LAS bf16x8*)(lds + PG8_SB(b, h) + boff + n * 2048 + k * 1024); } while (0)
#define PG8_MMA(ai, bj, At, Bt) do { __builtin_amdgcn_s_setprio(1); _Pragma("unroll") for (int m = 0; m < 4; ++m) _Pragma("unroll") for (int n = 0; n < 2; ++n) _Pragma("unroll") for (int k = 0; k < 2; ++k) \
        acc[ai][bj][m][n] = __builtin_amdgcn_mfma_f32_16x16x32_bf16(Bt[n][k], At[m][k], acc[ai][bj][m][n], 0, 0, 0); __builtin_amdgcn_s_setprio(0); } while (0)
#define PG8_WAIT_V(n) asm volatile("s_waitcnt vmcnt(" #n ")" ::: "memory")
#define PG8_WAIT_L(n) asm volatile("s_waitcnt lgkmcnt(" #n ")" ::: "memory")
#define PG8_BAR __builtin_amdgcn_s_barrier()
#define PG8_SCHED __builtin_amdgcn_sched_barrier(0)
    Unit cur, nxt; int ui = 0;
    if (!S.next(0, cur)) return;
    f32x4 acc[2][2][4][2];
#pragma unroll
    for (int a = 0; a < 2; ++a)
#pragma unroll
        for (int b = 0; b < 2; ++b)
#pragma unroll
            for (int m = 0; m < 4; ++m)
#pragma unroll
                for (int n = 0; n < 2; ++n) acc[a][b][m][n] = (f32x4){0.f, 0.f, 0.f, 0.f};
    bf16x8 At[4][2], B0[2][2], B1[2][2];
    const char* cA = (const char*)g.A + (size_t)cur.pm * tstep; const char* cB = (const char*)g.Bt + (size_t)cur.pn * tstep;
    S.a_ready(cur);
    if constexpr (SP2) {
        PG8_STAGE(PG8_SB(0, 0), cB, voffB); PG8_STAGE(PG8_SB(0, 1), cB + hstep, voffB); PG8_STAGE(PG8_SA(0, 0), cA, voffA); PG8_STAGE(PG8_SA(0, 1), cA + hstep, voffA);
        if (wr == 1) PG8_BAR;
        PG8_WAIT_V(2); PG8_BAR;
        PG8_STAGE(PG8_SB(1, 0), cB + kstep, voffB); PG8_STAGE(PG8_SA(1, 0), cA + kstep, voffA); PG8_STAGE(PG8_SB(1, 1), cB + hstep + kstep, voffB);
        PG8_WAIT_V(6); PG8_BAR;
    } else {
        PG8_STAGE(PG8_SB(0, 0), cB, voffB); PG8_STAGE(PG8_SA(0, 0), cA, voffA); PG8_STAGE(PG8_SB(0, 1), cB + hstep, voffB); PG8_STAGE(PG8_SA(0, 1), cA + hstep, voffA);
        if (wr == 1) PG8_BAR;
        PG8_WAIT_V(4); PG8_BAR;
        PG8_STAGE(PG8_SB(1, 0), cB + kstep, voffB); PG8_STAGE(PG8_SA(1, 0), cA + kstep, voffA); PG8_STAGE(PG8_SB(1, 1), cB + hstep + kstep, voffB);
        PG8_WAIT_V(6); PG8_BAR;
    }
    for (;;) {
        const bool has_next = S.next(ui + 1, nxt);
        const char* nA = has_next ? (const char*)g.A + (size_t)nxt.pm * tstep : cA; const char* nB = has_next ? (const char*)g.Bt + (size_t)nxt.pn * tstep : cB;
        for (int t = 0; t < nt; t += 2) {
            const bool last = (t == nt - 2);
            const char* a1 = cA + (size_t)(t + 1) * kstep;
            const char* a2 = last ? nA : cA + (size_t)(t + 2) * kstep; const char* b2 = last ? nB : cB + (size_t)(t + 2) * kstep;
            const char* a3 = a2 + kstep; const char* b3 = b2 + kstep;
            if (last && has_next) S.a_ready(nxt);
            if constexpr (SP2) {
            PG8_LDB(B0, 0, 0); PG8_LDB(B1, 0, 1); PG8_SCHED; PG8_LDA(At, 0, 0); PG8_STAGE(PG8_SA(1, 1), a1 + hstep, voffA);
            PG8_WAIT_V(8); PG8_WAIT_L(0); PG8_BAR; PG8_MMA(0, 0, At, B0); PG8_MMA(0, 1, At, B1); PG8_BAR; PG8_SCHED;
            PG8_LDA(At, 0, 1); PG8_STAGE(PG8_SB(0, 0), b2, voffB); PG8_STAGE(PG8_SB(0, 1), b2 + hstep, voffB); PG8_STAGE(PG8_SA(0, 0), a2, voffA);
            PG8_WAIT_V(8); PG8_WAIT_L(0); PG8_BAR; PG8_MMA(1, 0, At, B0); PG8_MMA(1, 1, At, B1); PG8_BAR; PG8_SCHED;
            PG8_LDB(B0, 1, 0); PG8_LDB(B1, 1, 1); PG8_SCHED; PG8_LDA(At, 1, 0); PG8_STAGE(PG8_SA(0, 1), a2 + hstep, voffA);
            PG8_WAIT_V(8); PG8_WAIT_L(0); PG8_BAR; PG8_MMA(0, 0, At, B0); PG8_MMA(0, 1, At, B1); PG8_BAR; PG8_SCHED;
            PG8_LDA(At, 1, 1); PG8_STAGE(PG8_SB(1, 0), b3, voffB); PG8_STAGE(PG8_SB(1, 1), b3 + hstep, voffB); PG8_STAGE(PG8_SA(1, 0), a3, voffA);
            PG8_WAIT_V(8); PG8_WAIT_L(0); PG8_BAR; PG8_MMA(1, 0, At, B0); PG8_MMA(1, 1, At, B1); PG8_BAR; PG8_SCHED;
            } else {
            PG8_LDB(B0, 0, 0); PG8_SCHED; PG8_LDA(At, 0, 0); PG8_STAGE(PG8_SA(1, 1), a1 + hstep, voffA);
            PG8_WAIT_L(8); PG8_BAR; PG8_WAIT_L(0); PG8_MMA(0, 0, At, B0); PG8_BAR; PG8_SCHED;
            PG8_LDB(B1, 0, 1); PG8_STAGE(PG8_SB(0, 0), b2, voffB);
            PG8_BAR; PG8_WAIT_L(0); PG8_MMA(0, 1, At, B1); PG8_BAR;
            PG8_LDA(At, 0, 1); PG8_STAGE(PG8_SA(0, 0), a2, voffA);
            PG8_BAR; PG8_WAIT_L(0); PG8_MMA(1, 0, At, B0); PG8_BAR; PG8_SCHED;
            PG8_STAGE(PG8_SB(0, 1), b2 + hstep, voffB);
            PG8_WAIT_V(6); PG8_BAR; PG8_MMA(1, 1, At, B1); PG8_BAR;
            PG8_LDB(B0, 1, 0); PG8_SCHED; PG8_LDA(At, 1, 0); PG8_STAGE(PG8_SA(0, 1), a2 + hstep, voffA);
            PG8_WAIT_L(8); PG8_BAR; PG8_WAIT_L(0); PG8_MMA(0, 0, At, B0); PG8_BAR; PG8_SCHED;
            PG8_LDB(B1, 1, 1); PG8_STAGE(PG8_SB(1, 0), b3, voffB);
            PG8_BAR; PG8_WAIT_L(0); PG8_MMA(0, 1, At, B1); PG8_BAR;
            PG8_LDA(At, 1, 1); PG8_STAGE(PG8_SA(1, 0), a3, voffA);
            PG8_BAR; PG8_WAIT_L(0); PG8_MMA(1, 0, At, B0); PG8_BAR; PG8_SCHED;
            PG8_STAGE(PG8_SB(1, 1), b3 + hstep, voffB);
            PG8_WAIT_V(6); PG8_BAR; PG8_MMA(1, 1, At, B1); PG8_BAR;
            }
        }
        if constexpr (ALIGN_EPI) { if (wr == 0) PG8_BAR; }
        if constexpr (!Epi::AFTER_DRAIN) { E(acc, cur, wr, wc, fr, fq); S.done(cur); }
        if (!has_next) break;
#pragma unroll
        for (int a = 0; a < 2; ++a)
#pragma unroll
            for (int b = 0; b < 2; ++b)
#pragma unroll
                for (int m = 0; m < 4; ++m)
#pragma unroll
                    for (int n = 0; n < 2; ++n) acc[a][b][m][n] = (f32x4){0.f, 0.f, 0.f, 0.f};
        cur = nxt; cA = nA; cB = nB; ++ui;
        if constexpr (ALIGN_EPI) { if (wr == 1) PG8_BAR; }
    }
    PG8_WAIT_V(0);
    if constexpr (!ALIGN_EPI) { if (wr == 0) PG8_BAR; }
    PG8_BAR;
    if constexpr (Epi::AFTER_DRAIN) { E.fused(acc, cur, wr, wc, fr, fq, lds, wid, lane); S.done(cur); }
#undef PG8_SA
#undef PG8_SB
#undef PG8_STAGE
#undef PG8_LDA
#undef PG8_LDB
#undef PG8_MMA
#undef PG8_WAIT_V
#undef PG8_WAIT_L
#undef PG8_BAR
#undef PG8_SCHED
}
}

typedef short bf16x8 __attribute__((ext_vector_type(8)));
typedef float f32x4 __attribute__((ext_vector_type(4)));
typedef unsigned u32x4 __attribute__((ext_vector_type(4)));
typedef unsigned u32x2 __attribute__((ext_vector_type(2)));
constexpr int NTHREADS = 512, NWAVES = 8, LDS_BYTES = 147456;
#endif
#ifdef HOST_EMU
#define DEV static inline
#define LDSQ
#define TIDX emu_tid()
#define BIDX emu_bid()
#define GDIM emu_gdim()
#define SYNCTHREADS() emu_syncthreads()
#define WAVE_SYNC() emu_wave_sync()
#define MFMA16(a, b, c) emu_mfma16(a, b, c)
#define SHFL_XOR(v, m) emu_shfl_xor(v, m)
#define BALLOT(p) emu_ballot(p)
#define EXP2F(x) exp2f(x)
#define LDS_ATOMIC_ADD(ptr, v) (*(ptr) += (v))
#define FETCH_ADD_U32(ptr, v) __atomic_fetch_add(ptr, v, __ATOMIC_RELAXED)
static inline unsigned f_as_u(float f) { union { unsigned u; float f; } c; c.f = f; return c.u; }
static inline unsigned cvtpk(float lo, float hi) { return (unsigned)f2bf(lo) | ((unsigned)f2bf(hi) << 16); }
#else
#define DEV __device__ __forceinline__
#define LDSQ LAS
__device__ __forceinline__ int opaque_tid() { int t = (int)threadIdx.x; asm volatile("" : "+v"(t)); return t; }
#define TIDX opaque_tid()
#define BIDX ((int)blockIdx.x)
#define GDIM ((int)gridDim.x)
#define SYNCTHREADS() __syncthreads()
#define WAVE_SYNC() asm volatile("s_waitcnt lgkmcnt(0)" ::: "memory")
#define MFMA16(a, b, c) __builtin_amdgcn_mfma_f32_16x16x32_bf16(a, b, c, 0, 0, 0)
#define SHFL_XOR(v, m) __shfl_xor(v, m)
#define BALLOT(p) __ballot(p)
#define EXP2F(x) __builtin_amdgcn_exp2f(x)
#define LDS_ATOMIC_ADD(ptr, v) atomicAdd((float*)(ptr), v)
#define FETCH_ADD_U32(ptr, v) __hip_atomic_fetch_add(ptr, v, __ATOMIC_RELAXED, __HIP_MEMORY_SCOPE_AGENT)
__device__ __forceinline__ unsigned f_as_u(float f) { return __float_as_uint(f); }
__device__ __forceinline__ unsigned cvtpk(float lo, float hi) { unsigned r; asm volatile("v_cvt_pk_bf16_f32 %0, %1, %2" : "=v"(r) : "v"(lo), "v"(hi)); return r; }
#endif

constexpr float LOG2E = 1.4426950408889634f, NEGF = -1e30f;
constexpr int NTH = 512, NWV = 8;
constexpr int A_STAGE = 0, A_STAGE_BYTES = 16384;
constexpr int A_IMP = 32768;
constexpr int A_BIAS = 65536;
constexpr int A_SELM = A_BIAS + 4352;
constexpr int A_MISC = A_SELM + 1024;
constexpr int A_END = A_MISC + 64;
HD int perm32k(int kk) { return (kk & 3) + 4 * ((kk >> 4) & 1) + 8 * ((kk >> 2) & 3); }

constexpr int HS_STRIDE = 272;
DEV void p2_compress_unit(const Params& p, LDSQ unsigned char* lds, int u) {
    const int tid = TIDX, lane = tid & 63, wave = tid >> 6, fr = lane & 15, fq = lane >> 4;
    constexpr int NCT = NCP / 32;
    const int ct = u % NCT, bg = (u / NCT) % (NB * NG), w = u / (NCT * NB * NG), c0 = 32 * ct;
    const bf16* src = p.kv[0] + (size_t)w * KVSZ + (size_t)bg * S * 64;
    const bf16* w1 = p.w1t[0] + (size_t)w * (128 * 2048);
    f32x4 acc[2] = {{0.f, 0.f, 0.f, 0.f}, {0.f, 0.f, 0.f, 0.f}};
    const bf16* a0 = src + (size_t)(c0 + fr) * 1024 + 8 * fq, *a1 = a0 + 16 * 1024, *bp = w1 + (size_t)(16 * wave + fr) * 2048 + 8 * fq;
#pragma unroll 8
    for (int ks = 0; ks < 64; ++ks) {
        const bf16x8 fa0 = *(const bf16x8*)(a0 + 32 * ks), fa1 = *(const bf16x8*)(a1 + 32 * ks), fb = *(const bf16x8*)(bp + 32 * ks);
        acc[0] = MFMA16(fa0, fb, acc[0]); acc[1] = MFMA16(fa1, fb, acc[1]);
    }
    const float pb = p.peb[0][w * 128 + 16 * wave + fr];
#pragma unroll
    for (int mt = 0; mt < 2; ++mt)
#pragma unroll
        for (int r = 0; r < 4; ++r) *(LDSQ bf16*)(lds + (16 * mt + 4 * fq + r) * HS_STRIDE + (16 * wave + fr) * 2) = f2bf(siluf(acc[mt][r] + pb));
    SYNCTHREADS();
    {
        const int mt = wave & 1, dt = wave >> 1; const bf16* w2 = p.w2t[0] + (size_t)w * (64 * 128) + (size_t)(16 * dt + fr) * 128 + 8 * fq;
        f32x4 o = {0.f, 0.f, 0.f, 0.f};
#pragma unroll
        for (int ks = 0; ks < 4; ++ks) { const bf16x8 fa = *(LDSQ const bf16x8*)(lds + (16 * mt + fr) * HS_STRIDE + (32 * ks + 8 * fq) * 2), fb = *(const bf16x8*)(w2 + 32 * ks); o = MFMA16(fa, fb, o); }
        const int d = 16 * dt + fr, cb = c0 + 16 * mt + 4 * fq;
        if (w == 0) {
#pragma unroll
            for (int r = 0; r < 4; ++r) p.kcvc[0][((size_t)bg * NCP + cb + r) * 64 + d] = (cb + r == NCP - 1) ? (bf16)0 : f2bf(o[r]);
        } else {
            u32x2 pk; pk[0] = cvtpk(o[0], o[1]); pk[1] = cvtpk(o[2], (cb + 3 == NCP - 1) ? 0.f : o[3]);
            *(u32x2*)(p.vct + ((size_t)bg * 64 + d) * NCP + (cb & ~31) + perm32k(cb & 31)) = pk;
        }
    }
    SYNCTHREADS();
}
constexpr int TS = 72;
DEV void p2_transpose_item(const Params& p, LDSQ unsigned char* lds, int it) {
    const int tid = TIDX, lane = tid & 63, wave = tid >> 6;
    const int nb = it % NSEL, bg = (it / NSEL) % (NB * NG), ten = it / (NSEL * NB * NG);
    const bf16* src = p.kv[0] + (size_t)(ten ? 5 : 3) * KVSZ + ((size_t)bg * S + 64 * nb) * 64;
    bf16* dst = (ten ? p.vtw : p.vts) + (size_t)bg * 64 * S + 64 * nb;
    LDSQ bf16* tb = (LDSQ bf16*)(lds + wave * (64 * TS * 2));
#pragma unroll
    for (int i = 0; i < 8; ++i) { const int row = 8 * i + (lane >> 3), ch = lane & 7; const bf16x8 v = *(const bf16x8*)(src + row * 64 + ch * 8);
        const int pr = (row & 32) + perm32k(row & 31);
#pragma unroll
        for (int j = 0; j < 8; ++j) tb[(ch * 8 + j) * TS + pr] = (bf16)v[j]; }
    WAVE_SYNC();
#pragma unroll
    for (int i = 0; i < 8; ++i) { const int d = 8 * i + (lane >> 3), ch = lane & 7; *(bf16x8*)(dst + (size_t)d * S + ch * 8) = *(LDSQ const bf16x8*)(tb + d * TS + ch * 8); }
    WAVE_SYNC();
}
DEV void p2_conv_item(const Params& p, long it) {
    const long row = it >> 6; const int c8 = (int)(it & 63) * 8, t = (int)(row % S);
    const bf16* hb = p.reg5[0] + R5SZ, *bb = hb + R5SZ, *cb = bb + R5SZ, *zb = cb + R5SZ;
    float y[8];
#pragma unroll
    for (int j = 0; j < 8; ++j) y[j] = 0.f;
#pragma unroll
    for (int k = 0; k < 3; ++k) { if (t - 2 + k < 0) continue; const size_t o = (size_t)(row - 2 + k) * 512 + c8;
        const bf16x8 h8 = *(const bf16x8*)(hb + o), cc8 = *(const bf16x8*)(cb + o); const f32x4 w0 = *(const f32x4*)(p.conv_w + k * 512 + c8), w1 = *(const f32x4*)(p.conv_w + k * 512 + c8 + 4);
#pragma unroll
        for (int j = 0; j < 8; ++j) y[j] += (j < 4 ? w0[j & 3] : w1[j & 3]) * (bf2f((bf16)cc8[j]) * bf2f((bf16)h8[j])); }
    const bf16x8 b8 = *(const bf16x8*)(bb + (size_t)row * 512 + c8), z8 = *(const bf16x8*)(zb + (size_t)row * 512 + c8);
    u32x4 o;
#pragma unroll
    for (int j = 0; j < 4; ++j) o[j] = cvtpk(bf2f((bf16)b8[2 * j]) * y[2 * j] * siluf(bf2f((bf16)z8[2 * j])), bf2f((bf16)b8[2 * j + 1]) * y[2 * j + 1] * siluf(bf2f((bf16)z8[2 * j + 1])));
    *(u32x4*)(p.mixed + (size_t)row * 1024 + 512 + c8) = o;
}
DEV void p2_phase(const Params& p, LDSQ unsigned char* lds) {
    const int tid = TIDX, wave = tid >> 6;
    constexpr int NCU = 2 * NB * NG * (NCP / 32);
    for (int u = BIDX; u < NCU; u += GDIM) p2_compress_unit(p, lds, u);
    const int gw = BIDX * NWV + wave, NGW = GDIM * NWV;
    for (int it = NGW - 1 - gw; it < 2 * NB * NG * NSEL; it += NGW) p2_transpose_item(p, lds, it);
    const long T = (long)GDIM * NTH;
    for (long it = (long)(GDIM - 1 - BIDX) * NTH + tid; it < (long)ROWS * 64; it += T) p2_conv_item(p, it);
}

DEV void qk_tile(LDSQ const unsigned char* kimg, const bf16x8 (&qf)[2], f32x4 (&s)[4], float init, int fr, int fq) {
#pragma unroll
    for (int kt = 0; kt < 4; ++kt) {
        f32x4 a = {init, init, init, init};
#pragma unroll
        for (int ks = 0; ks < 2; ++ks) { const bf16x8 kf = *(LDSQ const bf16x8*)(kimg + (16 * kt + fr) * 128 + (((4 * ks + fq) ^ (fr & 7)) << 4)); a = MFMA16(kf, qf[ks], a); }
        s[kt] = a;
    }
}
DEV void pv_tile(LDSQ const unsigned char* vimg, const f32x4 (&pv)[4], f32x4 (&o)[4], int fr, int fq) {
    bf16x8 pb[2];
#pragma unroll
    for (int i = 0; i < 2; ++i) { u32x4 w; w[0] = cvtpk(pv[2 * i][0], pv[2 * i][1]); w[1] = cvtpk(pv[2 * i][2], pv[2 * i][3]); w[2] = cvtpk(pv[2 * i + 1][0], pv[2 * i + 1][1]); w[3] = cvtpk(pv[2 * i + 1][2], pv[2 * i + 1][3]);
        pb[i] = (bf16x8)w; }
#pragma unroll
    for (int dt = 0; dt < 4; ++dt)
#pragma unroll
        for (int i = 0; i < 2; ++i) { const bf16x8 vf = *(LDSQ const bf16x8*)(vimg + (16 * dt + fr) * 128 + (((4 * i + fq) ^ (fr & 7)) << 4)); o[dt] = MFMA16(vf, pb[i], o[dt]); }
}
DEV void bias_mask(f32x4 (&s)[4], LDSQ const float* btab, int tqe, int kstride, int dmax, int h, int fq) {
#pragma unroll
    for (int kt = 0; kt < 4; ++kt)
#pragma unroll
        for (int r = 0; r < 4; ++r) { const int dist = tqe - kstride * (16 * kt + 4 * fq + r); const bool valid = dist >= 0 && dist <= dmax;
            const int bi = dist < 0 ? 0 : (dist > 128 ? 128 : dist); s[kt][r] = valid ? s[kt][r] + btab[bi * 8 + h] : NEGF; }
}
DEV float tile_max(const f32x4 (&s)[4]) {
    float m = s[0][0];
#pragma unroll
    for (int kt = 0; kt < 4; ++kt)
#pragma unroll
        for (int r = 0; r < 4; ++r) m = fmaxf(m, s[kt][r]);
    m = fmaxf(m, SHFL_XOR(m, 16)); m = fmaxf(m, SHFL_XOR(m, 32)); return m;
}
template <bool ELEM> DEV void softmax_pv(f32x4 (&s)[4], float& m, float& l, f32x4 (&o)[4], bool colsel, LDSQ const unsigned char* vimg, int fr, int fq) {
    float tmax = tile_max(s); if (!colsel) tmax = NEGF;
    const float mn = fmaxf(m, tmax), alpha = EXP2F(m - mn), mu = colsel ? mn : 1e30f; m = mn;
    float ps = 0.f;
#pragma unroll
    for (int kt = 0; kt < 4; ++kt)
#pragma unroll
        for (int r = 0; r < 4; ++r) { float e = EXP2F(s[kt][r] - mu); if (ELEM) e = s[kt][r] > -5e29f ? e : 0.f; s[kt][r] = e; ps += e; }
    l = l * alpha + ps;
#pragma unroll
    for (int dt = 0; dt < 4; ++dt) o[dt] = o[dt] * alpha;
    pv_tile(vimg, s, o, fr, fq);
}

DEV void attn_unit(const Params& p, LDSQ unsigned char* lds, int u) {
    const int tid = TIDX, lane = tid & 63, wave = tid >> 6, fr = lane & 15, fq = lane >> 4;
    const int blk = NSEL - 1 - u / (NB * NG), bg = u % (NB * NG), b = bg / NG, g = bg % NG, t0 = 64 * blk;
    const int r = fr & 3, h = 4 * g + r;
    LDSQ float* btab = (LDSQ float*)(lds + A_BIAS);
    LDSQ float* imp = (LDSQ float*)(lds + A_IMP);
    LDSQ unsigned long long* selm = (LDSQ unsigned long long*)(lds + A_SELM);
    int tq[2]; bf16x8 qf[2][2];
#pragma unroll
    for (int cg = 0; cg < 2; ++cg) { tq[cg] = t0 + 8 * wave + 4 * cg + (fr >> 2);
        const bf16* qp = p.q + (((size_t)b * NH + h) * S + tq[cg]) * 64 + 8 * fq; qf[cg][0] = *(const bf16x8*)qp; qf[cg][1] = *(const bf16x8*)(qp + 32); }
#define GATE(cg, br) p.gates[((size_t)b * S + tq[cg]) * 24 + (br) * 8 + h]
    for (int i = lane; i < 8 * 128; i += 64) imp[(8 * wave) * 128 + i] = 0.f;
    const int ncb = ((4 * blk + 2) >> 6) + 1, nslc = blk + 1, wb0 = blk > 8 ? blk - 8 : 0, nwin = blk - wb0 + 1, j_slc = 2 * ncb, j_win = j_slc + nslc, njobs = j_win + nwin;
    const bf16* kcb = p.kcvc[0] + (size_t)bg * NCP * 64; const bf16* vcb = p.vct + (size_t)bg * 64 * NCP;
    const bf16* ksb = p.kv[0] + 2 * KVSZ + (size_t)bg * S * 64; const bf16* vsb = p.vts + (size_t)bg * 64 * S;
    const bf16* kwb = p.kv[0] + 4 * KVSZ + (size_t)bg * S * 64; const bf16* vwb = p.vtw + (size_t)bg * 64 * S;
    const int srow = tid >> 3, sch = tid & 7, sdst = srow * 128 + ((sch ^ (srow & 7)) << 4);
    u32x4 rk = {0u, 0u, 0u, 0u}, rv = {0u, 0u, 0u, 0u};
#define STAGE_LOAD(j) do { const int j_ = (j); \
        if (j_ < j_slc) { const int cb_ = j_ < ncb ? j_ : j_ - ncb; rk = *(const u32x4*)(kcb + ((size_t)64 * cb_ + srow) * 64 + sch * 8); if (j_ >= ncb) rv = *(const u32x4*)(vcb + (size_t)srow * NCP + 64 * cb_ + sch * 8); } \
        else if (j_ < j_win) { const int n_ = j_ - j_slc; rk = *(const u32x4*)(ksb + ((size_t)64 * n_ + srow) * 64 + sch * 8); rv = *(const u32x4*)(vsb + (size_t)srow * S + 64 * n_ + sch * 8); } \
        else { const int n_ = wb0 + j_ - j_win; rk = *(const u32x4*)(kwb + ((size_t)64 * n_ + srow) * 64 + sch * 8); rv = *(const u32x4*)(vwb + (size_t)srow * S + 64 * n_ + sch * 8); } } while (0)
#define STAGE_WRITE(j) do { LDSQ unsigned char* sb_ = lds + A_STAGE + ((j) & 1) * A_STAGE_BYTES; *(LDSQ u32x4*)(sb_ + sdst) = rk; *(LDSQ u32x4*)(sb_ + 8192 + sdst) = rv; } while (0)
    STAGE_LOAD(0); STAGE_WRITE(0);
    SYNCTHREADS();
    float m[2] = {NEGF, NEGF}, l[2] = {0.f, 0.f};
    f32x4 o[2][4];
#pragma unroll
    for (int cg = 0; cg < 2; ++cg)
#pragma unroll
        for (int dt = 0; dt < 4; ++dt) o[cg][dt] = (f32x4){0.f, 0.f, 0.f, 0.f};
    unsigned long long mlo[2] = {0ull, 0ull}, mhi[2] = {0ull, 0ull};
    const float bfar = btab[128 * 8 + h];
    for (int j = 0; j < njobs; ++j) {
        if (j + 1 < njobs) STAGE_LOAD(j + 1);
        LDSQ const unsigned char* kimg = lds + A_STAGE + (j & 1) * A_STAGE_BYTES; LDSQ const unsigned char* vimg = kimg + 8192;
        if (j < ncb) {
#pragma unroll
            for (int cg = 0; cg < 2; ++cg) { f32x4 s[4]; qk_tile(kimg, qf[cg], s, 0.f, fr, fq); bias_mask(s, btab, tq[cg] - 31 - 16 * 64 * j, 16, 1 << 30, h, fq);
                const float mn = fmaxf(m[cg], tile_max(s)), alpha = EXP2F(m[cg] - mn); m[cg] = mn; float ps = 0.f;
#pragma unroll
                for (int kt = 0; kt < 4; ++kt)
#pragma unroll
                    for (int rr = 0; rr < 4; ++rr) ps += s[kt][rr] > -5e29f ? EXP2F(s[kt][rr] - mn) : 0.f;
                l[cg] = l[cg] * alpha + ps; }
            if (j == ncb - 1) {
#pragma unroll
                for (int cg = 0; cg < 2; ++cg) { float lt = l[cg]; lt += SHFL_XOR(lt, 16); lt += SHFL_XOR(lt, 32); l[cg] = 1.0f / fmaxf(lt, 1e-30f); }
            }
        } else if (j < j_slc) {
            const int cb = j - ncb;
#pragma unroll
            for (int cg = 0; cg < 2; ++cg) { f32x4 s[4]; qk_tile(kimg, qf[cg], s, 0.f, fr, fq); bias_mask(s, btab, tq[cg] - 31 - 16 * 64 * cb, 16, 1 << 30, h, fq);
#pragma unroll
                for (int kt = 0; kt < 4; ++kt) {
#pragma unroll
                    for (int rr = 0; rr < 4; ++rr) s[kt][rr] = s[kt][rr] > -5e29f ? EXP2F(s[kt][rr] - m[cg]) * l[cg] : 0.f;
                    float s4 = (s[kt][0] + s[kt][1]) + (s[kt][2] + s[kt][3]), p3 = s[kt][3];
                    s4 += SHFL_XOR(s4, 1); s4 += SHFL_XOR(s4, 2); p3 += SHFL_XOR(p3, 1); p3 += SHFL_XOR(p3, 2);
                    if (r == 0) { const int n = 16 * cb + 4 * kt + fq, ql = 8 * wave + 4 * cg + (fr >> 2); LDS_ATOMIC_ADD(&imp[ql * 128 + n], s4); if (n + 1 < NSEL) LDS_ATOMIC_ADD(&imp[ql * 128 + n + 1], p3); }
                }
                pv_tile(vimg, s, o[cg], fr, fq); }
            if (j == j_slc - 1) {
#pragma unroll
                for (int cg = 0; cg < 2; ++cg) { m[cg] = NEGF; l[cg] = 0.f; const float g0_ = GATE(cg, 0); float* ap = p.attn_acc + ((size_t)b * S + tq[cg]) * 512 + h * 64 + 4 * fq;
#pragma unroll
                    for (int dt = 0; dt < 4; ++dt) { *(f32x4*)(ap + 16 * dt) = o[cg][dt] * g0_; o[cg][dt] = (f32x4){0.f, 0.f, 0.f, 0.f}; } }
                WAVE_SYNC();
                for (int qq = 0; qq < 8; ++qq) { const int ql = 8 * wave + qq;
                    const int n0 = lane, n1 = lane + 64; const float v0 = imp[ql * 128 + n0], v1 = imp[ql * 128 + n1];
                    const unsigned k0 = n0 > blk ? 0u : ((n0 == 0 || n0 == blk || n0 == blk - 1) ? 0xFFFFFFFFu : f_as_u(v0) + 1u);
                    const unsigned k1 = n1 > blk ? 0u : ((n1 == blk || n1 == blk - 1) ? 0xFFFFFFFFu : f_as_u(v1) + 1u);
                    unsigned T = 0u;
                    for (int bit = 31; bit >= 0; --bit) { const unsigned cand = T | (1u << bit); const int cnt = __builtin_popcountll(BALLOT(k0 >= cand)) + __builtin_popcountll(BALLOT(k1 >= cand)); if (cnt >= KTOP) T = cand; }
                    const bool g0b = k0 > T, g1b = k1 > T; const int need = KTOP - (__builtin_popcountll(BALLOT(g0b)) + __builtin_popcountll(BALLOT(g1b)));
                    const unsigned long long be0 = BALLOT(k0 == T), be1 = BALLOT(k1 == T), lt = (1ull << lane) - 1ull;
                    const int r0 = __builtin_popcountll(be0 & lt), r1 = __builtin_popcountll(be0) + __builtin_popcountll(be1 & lt);
                    const unsigned long long s0 = BALLOT((g0b || (k0 == T && r0 < need)) && n0 <= blk), s1 = BALLOT((g1b || (k1 == T && r1 < need)) && n1 <= blk);
                    if (lane == 0) { selm[ql * 2] = s0; selm[ql * 2 + 1] = s1; } }
                WAVE_SYNC();
#pragma unroll
                for (int cg = 0; cg < 2; ++cg) { const int ql = 8 * wave + 4 * cg + (fr >> 2); mlo[cg] = selm[ql * 2]; mhi[cg] = selm[ql * 2 + 1]; }
            }
        } else if (j < j_win) {
            const int n = j - j_slc; const bool near = n + 2 >= blk;
#pragma unroll
            for (int cg = 0; cg < 2; ++cg) { const bool colsel = (((n < 64 ? mlo[cg] : mhi[cg]) >> (n & 63)) & 1ull) != 0ull;
                if (BALLOT(colsel) == 0ull) continue;
                f32x4 s[4];
                if (near) { qk_tile(kimg, qf[cg], s, 0.f, fr, fq); bias_mask(s, btab, tq[cg] - 64 * n, 1, 1 << 30, h, fq); softmax_pv<true>(s, m[cg], l[cg], o[cg], colsel, vimg, fr, fq); }
                else { qk_tile(kimg, qf[cg], s, bfar, fr, fq); softmax_pv<false>(s, m[cg], l[cg], o[cg], colsel, vimg, fr, fq); } }
            if (j == j_win - 1) {
#pragma unroll
                for (int cg = 0; cg < 2; ++cg) { float lt = l[cg]; lt += SHFL_XOR(lt, 16); lt += SHFL_XOR(lt, 32); const float sc = GATE(cg, 1) / fmaxf(lt, 1e-30f); m[cg] = NEGF; l[cg] = 0.f;
                    float* ap = p.attn_acc + ((size_t)b * S + tq[cg]) * 512 + h * 64 + 4 * fq;
#pragma unroll
                    for (int dt = 0; dt < 4; ++dt) { *(f32x4*)(ap + 16 * dt) = *(const f32x4*)(ap + 16 * dt) + o[cg][dt] * sc; o[cg][dt] = (f32x4){0.f, 0.f, 0.f, 0.f}; } }
            }
        } else {
            const int n = wb0 + j - j_win; const bool elem = (n + 2 >= blk) || (n + 8 == blk);
#pragma unroll
            for (int cg = 0; cg < 2; ++cg) { f32x4 s[4];
                if (elem) { qk_tile(kimg, qf[cg], s, 0.f, fr, fq); bias_mask(s, btab, tq[cg] - 64 * n, 1, WIN - 1, h, fq); softmax_pv<true>(s, m[cg], l[cg], o[cg], true, vimg, fr, fq); }
                else { qk_tile(kimg, qf[cg], s, bfar, fr, fq); softmax_pv<false>(s, m[cg], l[cg], o[cg], true, vimg, fr, fq); } }
        }
        if (j + 1 < njobs) STAGE_WRITE(j + 1);
        SYNCTHREADS();
    }
#undef STAGE_LOAD
#undef STAGE_WRITE
#pragma unroll
    for (int cg = 0; cg < 2; ++cg) { float lt = l[cg]; lt += SHFL_XOR(lt, 16); lt += SHFL_XOR(lt, 32); const float sc = GATE(cg, 2) / fmaxf(lt, 1e-30f);
        const size_t rowo = (size_t)b * S + tq[cg];
#pragma unroll
        for (int dt = 0; dt < 4; ++dt) { const int d0 = 16 * dt + 4 * fq; const f32x4 v = *(const f32x4*)(p.attn_acc + rowo * 512 + h * 64 + d0) + o[cg][dt] * sc;
            const u32x2 z = *(const u32x2*)(p.reg5[0] + rowo * 512 + h * 64 + d0);
            const float z0 = bf2f((bf16)(z[0] & 0xFFFFu)), z1 = bf2f((bf16)(z[0] >> 16)), z2 = bf2f((bf16)(z[1] & 0xFFFFu)), z3 = bf2f((bf16)(z[1] >> 16));
            u32x2 w; w[0] = cvtpk(v[0] * siluf(z0), v[1] * siluf(z1)); w[1] = cvtpk(v[2] * siluf(z2), v[3] * siluf(z3));
            *(u32x2*)(p.mixed + rowo * 1024 + h * 64 + d0) = w; } }
#undef GATE
}
DEV void attn_phase(const Params& p, LDSQ unsigned char* lds) {
    const int tid = TIDX;
    LDSQ float* btab = (LDSQ float*)(lds + A_BIAS);
    for (int i = tid; i < 129 * 8; i += NTH) btab[i] = p.bias_tab[i] * LOG2E;
    LDSQ int* misc = (LDSQ int*)(lds + A_MISC);
    constexpr int NUNITS = NB * NG * NSEL;
    for (;;) {
        SYNCTHREADS();
        if (tid == 0) misc[0] = (int)FETCH_ADD_U32(p.ctr, 1u);
        SYNCTHREADS();
        const int u = misc[0]; if (u >= NUNITS) break;
        attn_unit(p, lds, u);
    }
}
#ifndef HOST_EMU

__device__ __forceinline__ unsigned pk2(float lo, float hi) { return (unsigned)f2bf(lo) | ((unsigned)f2bf(hi) << 16); }
__device__ __forceinline__ float wave_sum(float v) {
#pragma unroll
    for (int o = 1; o < 64; o <<= 1) v += __shfl_xor(v, o);
    return v;
}
template <int MODE> __device__ __forceinline__ void p0_transpose_item(const Params& p, const float* W, int K, int N, int NPp, bf16* WT, LAS float* scr, int item, int lane) {
    const int nblk = NPp / 32, kb = item / nblk, nb = item % nblk, k0 = 64 * kb, n0 = 32 * nb;
    const int nn = n0 + (lane & 31); const int sc = MODE == 1 ? src_col(nn) : nn;
#pragma unroll 8
    for (int i = 0; i < 32; ++i) { const int kk = 2 * i + (lane >> 5); float v = 0.f;
        if (sc >= 0) { v = W[(size_t)(k0 + kk) * N + sc]; if (MODE == 1) v *= p.norm_w[k0 + kk]; }
        scr[kk * 33 + (lane & 31)] = v; }
    asm volatile("s_waitcnt lgkmcnt(0)" ::: "memory");
    const int c = lane & 7;
#pragma unroll
    for (int j = 0; j < 4; ++j) { const int n = (lane >> 3) + 8 * j; const LAS float* s = scr + (8 * c) * 33 + n;
        u32x4 o; o.x = pk2(s[0 * 33], s[1 * 33]); o.y = pk2(s[2 * 33], s[3 * 33]); o.z = pk2(s[4 * 33], s[5 * 33]); o.w = pk2(s[6 * 33], s[7 * 33]);
        *(u32x4*)(WT + (size_t)(n0 + n) * K + k0 + 8 * c) = o; }
    asm volatile("s_waitcnt lgkmcnt(0)" ::: "memory");
}
__device__ __forceinline__ void p0_prologue(const Params& p, LAS unsigned char* lds) {
    const int tid = threadIdx.x, lane = tid & 63, wave = tid >> 6;
    LAS float* scr = (LAS float*)(lds + wave * 16384);
    const int gw = blockIdx.x * NWAVES + wave, NGW = gridDim.x * NWAVES;
    constexpr int I_IN = (DM / 64) * (NP / 32), I_OUT = (DM / 64) * (DM / 32), I_W1 = (2048 / 64) * (128 / 32), I_W2 = (128 / 64) * (64 / 32);
    constexpr int NITEMS = I_IN + I_OUT + 2 * I_W1 + 2 * I_W2;
    for (int it = gw; it < NITEMS; it += NGW) {
        int r = it;
        if (r < I_IN) { p0_transpose_item<1>(p, p.w_in, DM, INCOLS, NP, p.wt_in, scr, r, lane); continue; } r -= I_IN;
        if (r < I_OUT) { p0_transpose_item<0>(p, p.w_out, DM, DM, DM, p.wt_out, scr, r, lane); continue; } r -= I_OUT;
        if (r < I_W1) { p0_transpose_item<0>(p, p.w_ck1, 2048, 128, 128, p.w1t[0], scr, r, lane); continue; } r -= I_W1;
        if (r < I_W1) { p0_transpose_item<0>(p, p.w_cv1, 2048, 128, 128, p.w1t[1], scr, r, lane); continue; } r -= I_W1;
        if (r < I_W2) { p0_transpose_item<0>(p, p.w_ck2, 128, 64, 64, p.w2t[0], scr, r, lane); continue; } r -= I_W2;
        p0_transpose_item<0>(p, p.w_cv2, 128, 64, 64, p.w2t[1], scr, r, lane);
    }
    for (int task = (NGW - 1 - gw); task < 256; task += NGW) { const int w = task >> 7, h = task & 127;
        const float* w1 = w ? p.w_cv1 : p.w_ck1; const float* pe = w ? p.pe_v : p.pe_k; float a = 0.f;
        for (int jd = lane; jd < 2048; jd += 64) a += pe[jd] * w1[(size_t)jd * 128 + h];
        a = wave_sum(a); if (lane == 0) p.peb[w][h] = a; }
    if (blockIdx.x == gridDim.x - 1) for (int i = tid; i < 129 * 8; i += NTHREADS) prep_bias_body(p, i);
    for (int m = gw; m < ROWS; m += NGW) {
        const f32x4* xr = (const f32x4*)(p.x + (size_t)m * DM) + lane; f32x4 v[4]; float s = 0.f;
#pragma unroll
        for (int j = 0; j < 4; ++j) { v[j] = xr[64 * j]; s += (v[j].x * v[j].x + v[j].y * v[j].y) + (v[j].z * v[j].z + v[j].w * v[j].w); }
        s = wave_sum(s);
        u32x2* o8 = (u32x2*)(p.xb + (size_t)m * DM) + lane;
#pragma unroll
        for (int j = 0; j < 4; ++j) { u32x2 w; w.x = pk2(v[j].x, v[j].y); w.y = pk2(v[j].z, v[j].w); o8[64 * j] = w; }
        if (lane == 0) p.rstd[m] = 1.0f / sqrtf(s * (1.0f / DM) + 1e-6f);
    }
}
struct EpiProj {
    static constexpr bool PERM = true, AFTER_DRAIN = false;
    const float* rstd; bf16* q; bf16* kv0; bf16* r50; float* gates;
    __device__ __forceinline__ void operator()(const f32x4 (&acc)[2][2][4][2], const pg8::Unit& u, int wr, int wc, int fr, int fq) const {
#pragma unroll
        for (int ai = 0; ai < 2; ++ai)
#pragma unroll
            for (int m = 0; m < 4; ++m) {
                const int row = u.pm * 256 + ai * 128 + wr * 64 + m * 16 + fr; const float rs = rstd[row]; const int b = row / S, s = row % S;
#pragma unroll
                for (int bj = 0; bj < 2; ++bj) {
                    const int col0 = u.pn * 256 + bj * 128 + wc * 32 + 8 * fq;
                    f32x4 v0 = acc[ai][bj][m][0] * rs, v1 = acc[ai][bj][m][1] * rs;
                    if (col0 >= 3840) {
                        if (col0 < 3864) { float* gp = gates + ((size_t)b * S + s) * 24 + (col0 - 3840);
                            *(f32x4*)gp = (f32x4){sigmf(v0[0]), sigmf(v0[1]), sigmf(v0[2]), sigmf(v0[3])}; *(f32x4*)(gp + 4) = (f32x4){sigmf(v1[0]), sigmf(v1[1]), sigmf(v1[2]), sigmf(v1[3])}; }
                        continue; }
                    bf16* dst;
                    if (col0 < 512) { v0 = v0 * QSCALE; v1 = v1 * QSCALE; dst = q + (((size_t)b * NH + (col0 >> 6)) * S + s) * 64 + (col0 & 63); }
                    else if (col0 < 1280) { const int j = (col0 - 512) >> 7, g = ((col0 - 512) >> 6) & 1; dst = kv0 + (size_t)j * KVSZ + (((size_t)b * NG + g) * S + s) * 64 + (col0 & 63); }
                    else { const int r = (col0 - 1280) >> 9, c = (col0 - 1280) & 511; dst = r50 + (size_t)r * R5SZ + ((size_t)b * S + s) * 512 + c; }
                    u32x4 w; w.x = pg8::cvt_pk_bf16(v0[0], v0[1]); w.y = pg8::cvt_pk_bf16(v0[2], v0[3]); w.z = pg8::cvt_pk_bf16(v1[0], v1[1]); w.w = pg8::cvt_pk_bf16(v1[2], v1[3]);
                    *(u32x4*)dst = w;
                }
            }
    }
};
struct EpiOut {
    static constexpr bool PERM = false, AFTER_DRAIN = false;
    const float* x; float* out; float* rowss;
    __device__ __forceinline__ void operator()(const f32x4 (&acc)[2][2][4][2], const pg8::Unit& u, int wr, int wc, int fr, int fq) const {
#pragma unroll
        for (int ai = 0; ai < 2; ++ai)
#pragma unroll
            for (int m = 0; m < 4; ++m) {
                const int row = u.pm * 256 + ai * 128 + wr * 64 + m * 16 + fr; float ss = 0.f;
#pragma unroll
                for (int bj = 0; bj < 2; ++bj)
#pragma unroll
                    for (int n = 0; n < 2; ++n) { const size_t off = (size_t)row * DM + u.pn * 256 + bj * 128 + wc * 32 + 16 * n + 4 * fq;
                        const f32x4 y = *(const f32x4*)(x + off) + acc[ai][bj][m][n]; *(f32x4*)(out + off) = y; ss += (y[0] * y[0] + y[1] * y[1]) + (y[2] * y[2] + y[3] * y[3]); }
                ss += __shfl_xor(ss, 16); ss += __shfl_xor(ss, 32);
                if (fq == 0) rowss[(size_t)row * 16 + u.pn * 4 + wc] = ss;
            }
    }
};
__device__ __forceinline__ void p4_final_norm(const Params& p) {
    const int tid = opaque_tid(), lane = tid & 63, wave = tid >> 6; const int gw = blockIdx.x * NWAVES + wave, NGW = gridDim.x * NWAVES;
    f32x4 w4[4];
#pragma unroll
    for (int j = 0; j < 4; ++j) w4[j] = *((const f32x4*)p.fnw + lane + 64 * j);
    for (int m = gw; m < ROWS; m += NGW) {
        float s = lane < 16 ? p.rowss[(size_t)m * 16 + lane] : 0.f;
        s += __shfl_xor(s, 1); s += __shfl_xor(s, 2); s += __shfl_xor(s, 4); s += __shfl_xor(s, 8); s = __shfl(s, 0);
        const float r = 1.0f / sqrtf(s * (1.0f / DM) + 1e-6f);
        f32x4* yr = (f32x4*)(p.out + (size_t)m * DM) + lane;
#pragma unroll
        for (int j = 0; j < 4; ++j) yr[64 * j] = yr[64 * j] * r * w4[j];
    }
}

__global__ void __launch_bounds__(NTHREADS, 2) mega_fwd(Params p) {
    extern __shared__ __attribute__((aligned(16))) unsigned char lds_raw[];
    LAS unsigned char* lds = (LAS unsigned char*)lds_raw;
    volatile LAS unsigned* st = (volatile LAS unsigned*)(lds + LDS_BYTES - 64);
    if (threadIdx.x < 16) st[threadIdx.x] = 0u;
    __syncthreads();
    const XcdBarrier bar = xcd_barrier_post(p.bar, st);
    const long T = (long)gridDim.x * NTHREADS, t0 = (long)blockIdx.x * NTHREADS + threadIdx.x;
#define SWEEP(name, n) for (long g_ = t0; g_ < (long)(n); g_ += T) name##_body(p, g_)
    p0_prologue(p, lds);
    xcd_barrier(bar);
    {
        pg8::Gemm g{p.xb, p.wt_in, ROWS, NP, DM}; pg8::StaticOrder so; so.init(ROWS, NP, (int)gridDim.x, (int)blockIdx.x);
        EpiProj E{p.rstd, p.q, p.kv[0], p.reg5[0], p.gates};
        pg8::gemm_phase<EpiProj, pg8::StaticOrder, true, true>(lds, g, so, E);
    }
    xcd_barrier(bar);
    p2_phase(p, lds);
    xcd_barrier(bar);
    attn_phase(p, lds);
    xcd_barrier(bar);
    {
        pg8::Gemm g{p.mixed, p.wt_out, ROWS, DM, DM}; pg8::StaticOrder so; so.init(ROWS, DM, (int)gridDim.x, (int)blockIdx.x);
        EpiOut E{p.x, p.out, p.rowss};
        pg8::gemm_phase<EpiOut, pg8::StaticOrder, true, true>(lds, g, so, E);
    }
    xcd_barrier(bar);
    p4_final_norm(p);
}

extern "C" void kernel_launch(void* const* d_in, const int* in_sizes, int n_in, void* d_out, int out_size, void* d_ws, size_t ws_size, hipStream_t stream) {
    static int grid = 0;
    if (grid == 0) {
        int dev = 0, cus = 0, per_cu = 0;
        if (hipGetDevice(&dev) != hipSuccess || hipDeviceGetAttribute(&cus, hipDeviceAttributeMultiprocessorCount, dev) != hipSuccess) { fprintf(stderr, "kernel_launch: device query failed\n"); grid = -1; return; }
        if (hipFuncSetAttribute((const void*)mega_fwd, hipFuncAttributeMaxDynamicSharedMemorySize, LDS_BYTES) != hipSuccess) { fprintf(stderr, "kernel_launch: hipFuncSetAttribute failed\n"); grid = -1; return; }
        if (hipOccupancyMaxActiveBlocksPerMultiprocessor(&per_cu, (const void*)mega_fwd, NTHREADS, LDS_BYTES) != hipSuccess || per_cu < 1) { fprintf(stderr, "kernel_launch: occupancy query says %d blocks per CU\n", per_cu); grid = -1; return; }
        (void)hipGetLastError();
        grid = cus;
    }
    if (grid < 0) return;
    Params p; memset(&p, 0, sizeof(p));
    const float** ins[13] = {&p.x, &p.norm_w, &p.w_in, &p.w_ck1, &p.w_ck2, &p.pe_k, &p.w_cv1, &p.w_cv2, &p.pe_v, &p.conv_w, &p.w_out, &p.rel_bias, &p.fnw};
    for (int i = 0; i < 13; ++i) *ins[i] = (const float*)d_in[i];
    p.out = (float*)d_out;
    const size_t need = carve(p, (char*)d_ws);
    if (need > ws_size) { fprintf(stderr, "workspace too small: need %zu have %zu\n", need, ws_size); return; }
    if (hipMemsetAsync(p.bar, 0, 16384, stream) != hipSuccess) { fprintf(stderr, "kernel_launch: memset failed\n"); return; }
    hipLaunchKernelGGL(mega_fwd, dim3(grid), dim3(NTHREADS), LDS_BYTES, stream, p);
}
#endif
```

```cpp
#ifndef HOST_EMU
#include <hip/hip_runtime.h>
#include <cstdio>
#include <cstdint>
#include <cstring>
#define HD __host__ __device__ __forceinline__
#else
#include <cmath>
#include <cstdio>
#include <cstdint>
#include <cstring>
#define HD static inline
#endif

#ifndef SEQ
#define SEQ 8192
#endif
typedef unsigned short bf16;
constexpr int NB = 2, S = SEQ, DM = 1024, NH = 8, HDIM = 64, NG = 2, NR = 4, DATT = 512, DCONV = 512;
constexpr int INCOLS = 3864, NP = 4096, NCMP = S / 16 - 1, NCP = S / 16, NSEL = S / 64, KTOP = (NSEL < 16 ? NSEL : 16);
constexpr int WIN = 512, ROWS = NB * S;
constexpr long KVSZ = (long)NB * NG * S * 64, R5SZ = (long)ROWS * 512;
constexpr float QSCALE = 0.125f * 1.4426950408889634f, INV_LOG2E = 0.6931471805599453f;

HD float bf2f(bf16 v) { union { unsigned u; float f; } c; c.u = ((unsigned)v) << 16; return c.f; }
HD bf16 f2bf(float f) { union { unsigned u; float f; } c; c.f = f; unsigned u = c.u; unsigned r = u + 0x7FFFu + ((u >> 16) & 1u); return (bf16)(r >> 16); }
HD float siluf(float v) { return v / (1.f + expf(-v)); }
HD float sigmf(float v) { return 1.f / (1.f + expf(-v)); }

struct Params {
    const float *x, *norm_w, *w_in, *w_ck1, *w_ck2, *pe_k, *w_cv1, *w_cv2, *pe_v, *conv_w, *w_out, *rel_bias, *fnw;
    float* out;
    unsigned* bar;
    bf16 *wt_in, *wt_out, *w1t[2], *w2t[2];
    float *peb[2], *bias_tab;
    bf16* xb; float* rstd;
    bf16 *q, *kv[6], *reg5[5];
    float* gates;
    float* hid;
    bf16* kcvc[2];
    float* imp; int* idx; float* attn_acc; bf16* mixed; float* rowss;
    bf16 *vts, *vtw, *vct; unsigned* ctr;
};

HD int t5_bucket(int d) {
    if (d >= 128) return 31;
    const unsigned long long lo = 0x81041088929fffeull, hi = 0x2000800802008ull;
    if (d < 64) return __builtin_popcountll(lo & ((2ull << d) - 1ull));
    return __builtin_popcountll(lo) + __builtin_popcountll(hi & ((2ull << (d - 64)) - 1ull));
}
HD int src_col(int n) { return n < 1280 ? n : (n < 3840 ? n + 24 : (n < 3864 ? 1280 + (n - 3840) : -1)); }
HD void prep_wtin_body(const Params& p, long gid) {
    const int n = (int)(gid / DM), k = (int)(gid % DM); const int c = src_col(n);
    p.wt_in[gid] = c < 0 ? (bf16)0 : f2bf(p.norm_w[k] * p.w_in[(long)k * INCOLS + c]);
}
HD void prep_wtout_body(const Params& p, long gid) {
    const int n = (int)(gid / DM), k = (int)(gid % DM);
    p.wt_out[gid] = f2bf(p.w_out[(long)k * DM + n]);
}
HD void prep_w1t_body(const Params& p, long gid) {
    const int w = (int)(gid / (128 * 2048)), r = (int)(gid % (128 * 2048)), h = r / 2048, jd = r % 2048;
    const float* w1 = w ? p.w_cv1 : p.w_ck1;
    p.w1t[w][r] = f2bf(w1[(long)jd * 128 + h]);
}
HD void prep_w2t_body(const Params& p, long gid) {
    const int w = (int)(gid / (64 * 128)), r = (int)(gid % (64 * 128)), d = r / 128, h = r % 128;
    const float* w2 = w ? p.w_cv2 : p.w_ck2;
    p.w2t[w][r] = f2bf(w2[h * 64 + d]);
}
HD void prep_peb_body(const Params& p, long gid) {
    const int w = (int)(gid / 128), h = (int)(gid % 128);
    const float* w1 = w ? p.w_cv1 : p.w_ck1; const float* pe = w ? p.pe_v : p.pe_k;
    float a = 0.f; for (int jd = 0; jd < 2048; ++jd) a += pe[jd] * w1[(long)jd * 128 + h];
    p.peb[w][h] = a;
}
HD void prep_bias_body(const Params& p, long gid) {
    const int d = (int)(gid / 8), h = (int)(gid % 8); const int bk = t5_bucket(d);
    p.bias_tab[gid] = p.rel_bias[bk * 8 + h];
}
HD void prep_x_body(const Params& p, long row) {
    const float* xr = p.x + row * DM; float ss = 0.f;
    for (int k = 0; k < DM; ++k) { const float v = xr[k]; ss += v * v; p.xb[row * DM + k] = f2bf(v); }
    p.rstd[row] = 1.0f / sqrtf(ss / DM + 1e-6f);
}
HD void store_proj(const Params& p, int row, int n, float v) {
    const int b = row / S, s = row % S;
    if (n < 512) { const int h = n >> 6, d = n & 63; p.q[(((long)b * NH + h) * S + s) * 64 + d] = f2bf(v * QSCALE); }
    else if (n < 1280) { const int j = (n - 512) >> 7, g = ((n - 512) >> 6) & 1, d = n & 63; p.kv[j][(((long)b * NG + g) * S + s) * 64 + d] = f2bf(v); }
    else if (n < 3840) { const int r = (n - 1280) >> 9, c = (n - 1280) & 511; p.reg5[r][((long)b * S + s) * 512 + c] = f2bf(v); }
    else if (n < 3864) { p.gates[((long)b * S + s) * 24 + (n - 3840)] = sigmf(v); }
}
HD void compress1_body(const Params& p, long gid) {
    const int h = (int)(gid % 128); long r = gid / 128; const int c = (int)(r % NCMP); r /= NCMP; const int g = (int)(r % NG); r /= NG; const int b = (int)(r % NB); const int w = (int)(r / NB);
    const bf16* src = p.kv[w] + (((long)b * NG + g) * S + 16 * c) * 64;
    const bf16* wr = p.w1t[w] + (long)h * 2048;
    float a = p.peb[w][h];
    for (int jd = 0; jd < 2048; ++jd) a += bf2f(src[jd]) * bf2f(wr[jd]);
    p.hid[((((long)w * NB + b) * NG + g) * NCP + c) * 128 + h] = a;
}
HD void compress2_body(const Params& p, long gid) {
    const int d = (int)(gid % 64); long r = gid / 64; const int c = (int)(r % NCMP); r /= NCMP; const int g = (int)(r % NG); r /= NG; const int b = (int)(r % NB); const int w = (int)(r / NB);
    const float* hp = p.hid + ((((long)w * NB + b) * NG + g) * NCP + c) * 128;
    const bf16* wr = p.w2t[w] + d * 128;
    float a = 0.f;
    for (int h = 0; h < 128; ++h) a += bf2f(f2bf(siluf(hp[h]))) * bf2f(wr[h]);
    p.kcvc[w][(((long)b * NG + g) * NCP + c) * 64 + d] = f2bf(a);
}
HD float dot64(const bf16* q, const bf16* k) { float a = 0.f;
#pragma unroll 8
    for (int d = 0; d < 64; ++d) a += bf2f(q[d]) * bf2f(k[d]);
    return a; }

HD void cmp_body(const Params& p, long gid) {
    const int t = (int)(gid % S); const int g = (int)((gid / S) % NG); const int b = (int)(gid / ((long)S * NG));
    const int nv = t >= 31 ? (t - 31) / 16 + 1 : 0;
    float* imp = p.imp + gid * 128;
    for (int n = 0; n < 128; ++n) imp[n] = 0.f;
    const bf16* kc = p.kcvc[0] + ((long)b * NG + g) * NCP * 64;
    const bf16* vc = p.kcvc[1] + ((long)b * NG + g) * NCP * 64;
    for (int r = 0; r < NR; ++r) {
        const int h = g * NR + r;
        const bf16* qp = p.q + (((long)b * NH + h) * S + t) * 64;
        const bf16* q = qp; float o[64];
#pragma unroll
        for (int d = 0; d < 64; ++d) o[d] = 0.f;
        float m = -1e30f;
        for (int c = 0; c < nv; ++c) { const int dist = t - (16 * c + 31); const float s = dot64(q, kc + c * 64) * INV_LOG2E + p.bias_tab[(dist < 128 ? dist : 128) * 8 + h]; m = fmaxf(m, s); }
        float l = 0.f;
        for (int c = 0; c < nv; ++c) { const int dist = t - (16 * c + 31); const float s = dot64(q, kc + c * 64) * INV_LOG2E + p.bias_tab[(dist < 128 ? dist : 128) * 8 + h]; l += expf(s - m); }
        const float inv = 1.f / fmaxf(l, 1e-30f);
        for (int c = 0; c < nv; ++c) {
            const int dist = t - (16 * c + 31); const float s = dot64(q, kc + c * 64) * INV_LOG2E + p.bias_tab[(dist < 128 ? dist : 128) * 8 + h];
            const float pr = expf(s - m) * inv;
#pragma unroll
            for (int d = 0; d < 64; ++d) o[d] += pr * bf2f(vc[c * 64 + d]);
            imp[c >> 2] += pr; if ((c & 3) == 3) imp[(c >> 2) + 1] += pr;
        }
        const float g0 = p.gates[((long)b * S + t) * 24 + 0 * 8 + h];
        float* ao = p.attn_acc + ((long)b * S + t) * 512 + h * 64;
#pragma unroll
        for (int d = 0; d < 64; ++d) ao[d] = g0 * o[d];
    }
    const int blk = t >> 6;
    for (int n = 0; n < NSEL; ++n) { const bool forced = (n == 0) || (n == blk) || (n == blk - 1); imp[n] = forced ? 1e3f : (n <= blk ? imp[n] : -1.0f); }
    int* idx = p.idx + gid * 16;
    for (int k = 0; k < KTOP; ++k) {
        float best = -3e38f; int bi = 0;
        for (int n = 0; n < NSEL; ++n) { const float v = imp[n]; if (v > best) { best = v; bi = n; } }
        idx[k] = bi; imp[bi] = -3.4e38f;
    }
}
HD void slcwin_body(const Params& p, long gid) {
    const int t = (int)(gid % S); const int h = (int)((gid / S) % NH); const int b = (int)(gid / ((long)S * NH)); const int g = h / NR;
    const bf16* qp = p.q + (((long)b * NH + h) * S + t) * 64;
    const bf16* q = qp; float o[64];
#pragma unroll
    for (int d = 0; d < 64; ++d) o[d] = 0.f;
    const long kvoff = ((long)b * NG + g) * S * 64;
    float* ai = p.attn_acc + ((long)b * S + t) * 512 + h * 64;
    {
        const bf16* K = p.kv[2] + kvoff; const bf16* V = p.kv[3] + kvoff;
        const int* idx = p.idx + (((long)b * NG + g) * S + t) * 16;
        float m = -1e30f, l = 0.f;
        for (int k = 0; k < KTOP; ++k) {
            const int n = idx[k];
            for (int j = 0; j < 64; ++j) {
                const int pos = n * 64 + j, dist = t - pos; if (dist < 0) continue;
                const float s = dot64(q, K + (long)pos * 64) * INV_LOG2E + p.bias_tab[(dist < 128 ? dist : 128) * 8 + h];
                if (s > m) { const float f = expf(m - s); l *= f;
#pragma unroll
                    for (int d = 0; d < 64; ++d) o[d] *= f;
                    m = s; }
                const float pr = expf(s - m); l += pr;
#pragma unroll
                for (int d = 0; d < 64; ++d) o[d] += pr * bf2f(V[(long)pos * 64 + d]);
            }
        }
        const float g1 = p.gates[((long)b * S + t) * 24 + 1 * 8 + h] / fmaxf(l, 1e-30f);
#pragma unroll
        for (int d = 0; d < 64; ++d) { ai[d] += g1 * o[d]; o[d] = 0.f; }
    }
    {
        const bf16* K = p.kv[4] + kvoff; const bf16* V = p.kv[5] + kvoff;
        float m = -1e30f, l = 0.f;
        const int lo = t - (WIN - 1) > 0 ? t - (WIN - 1) : 0;
        for (int pos = lo; pos <= t; ++pos) {
            const int dist = t - pos;
            const float s = dot64(q, K + (long)pos * 64) * INV_LOG2E + p.bias_tab[(dist < 128 ? dist : 128) * 8 + h];
            if (s > m) { const float f = expf(m - s); l *= f;
#pragma unroll
                for (int d = 0; d < 64; ++d) o[d] *= f;
                m = s; }
            const float pr = expf(s - m); l += pr;
#pragma unroll
            for (int d = 0; d < 64; ++d) o[d] += pr * bf2f(V[(long)pos * 64 + d]);
        }
        const float g2 = p.gates[((long)b * S + t) * 24 + 2 * 8 + h] / fmaxf(l, 1e-30f);
        const bf16* z = p.reg5[0] + ((long)b * S + t) * 512 + h * 64;
        bf16* mo = p.mixed + ((long)b * S + t) * 1024 + h * 64;
#pragma unroll
        for (int d = 0; d < 64; ++d) mo[d] = f2bf((ai[d] + g2 * o[d]) * siluf(bf2f(z[d])));
    }
}
HD void conv_body(const Params& p, long gid) {
    const int ch = (int)(gid % 512); const int t = (int)((gid / 512) % S); const int b = (int)(gid / (512L * S));
    const long base = ((long)b * S + t) * 512 + ch;
    float y = 0.f;
    for (int k = 0; k < 3; ++k) { const int tt = t - 2 + k; if (tt < 0) continue; const long o = base - (long)(2 - k) * 512;
        y += p.conv_w[k * 512 + ch] * (bf2f(p.reg5[3][o]) * bf2f(p.reg5[1][o])); }
    const float v = bf2f(p.reg5[2][base]) * y * siluf(bf2f(p.reg5[4][base]));
    p.mixed[((long)b * S + t) * 1024 + 512 + ch] = f2bf(v);
}
HD void final_norm_body(const Params& p, long row) {
    float* yr = p.out + row * DM; float ss = 0.f;
    for (int k = 0; k < DM; ++k) ss += yr[k] * yr[k];
    const float r = 1.0f / sqrtf(ss / DM + 1e-6f);
    for (int k = 0; k < DM; ++k) yr[k] = yr[k] * r * p.fnw[k];
}

static inline size_t carve(Params& p, char* base) {
    size_t off = 0; auto take = [&](size_t bytes) { char* r = base ? base + off : nullptr; off += (bytes + 255) & ~(size_t)255; return r; };
    p.bar = (unsigned*)take(16384);
    p.wt_in = (bf16*)take((size_t)NP * DM * 2); p.wt_out = (bf16*)take((size_t)DM * DM * 2);
    for (int w = 0; w < 2; ++w) p.w1t[w] = (bf16*)take(128 * 2048 * 2);
    for (int w = 0; w < 2; ++w) p.w2t[w] = (bf16*)take(64 * 128 * 2);
    for (int w = 0; w < 2; ++w) p.peb[w] = (float*)take(128 * 4);
    p.bias_tab = (float*)take(129 * 8 * 4);
    p.xb = (bf16*)take((size_t)ROWS * DM * 2); p.attn_acc = (float*)p.xb;
    p.rstd = (float*)take((size_t)ROWS * 4);
    p.q = (bf16*)take((size_t)NB * NH * S * 64 * 2);
    for (int j = 0; j < 6; ++j) p.kv[j] = (bf16*)take((size_t)NB * NG * S * 64 * 2);
    for (int j = 0; j < 5; ++j) p.reg5[j] = (bf16*)take((size_t)ROWS * 512 * 2);
    p.gates = (float*)take((size_t)ROWS * 24 * 4);
    p.hid = (float*)take((size_t)2 * NB * NG * NCP * 128 * 4);
    for (int w = 0; w < 2; ++w) p.kcvc[w] = (bf16*)take((size_t)NB * NG * NCP * 64 * 2);
    p.imp = (float*)take((size_t)NB * NG * S * 128 * 4);
    p.idx = (int*)take((size_t)NB * NG * S * 16 * 4);
    p.mixed = (bf16*)take((size_t)ROWS * 1024 * 2);
    p.rowss = (float*)take((size_t)ROWS * 16 * 4);
    p.vts = (bf16*)take((size_t)KVSZ * 2); p.vtw = (bf16*)take((size_t)KVSZ * 2); p.vct = (bf16*)take((size_t)NB * NG * 64 * NCP * 2);
    p.ctr = p.bar + 3584;
    return off;
}

#ifndef HOST_EMU
#define LAS __attribute__((address_space(3)))
#define XB_TMO      128
#define XB_XCNT(j)  (256  + 64 * (j))
#define XB_XSUB(j)  (1280 + 64 * (j))
#define XB_XGEN(j)  (2304 + 64 * (j))
#define XB_TOP      3328
#define XB_TOPGEN   3392
#define XCD_BAR_WORDS 3456
#define XB_SPIN_CAP (1u << 22)
__device__ __forceinline__ unsigned xb_ld(unsigned* p)              { return __hip_atomic_load(p, __ATOMIC_RELAXED, __HIP_MEMORY_SCOPE_AGENT); }
__device__ __forceinline__ unsigned xb_add(unsigned* p, unsigned v) { return __hip_atomic_fetch_add(p, v, __ATOMIC_RELAXED, __HIP_MEMORY_SCOPE_AGENT); }
__device__ __forceinline__ unsigned xb_xcc_id() { return (unsigned)__builtin_amdgcn_s_getreg((3 << 11) | 20) & 0xFu; }
#define XB_SPIN(cond, bar) do { unsigned _sp = 0; while (cond) { __builtin_amdgcn_s_sleep(1); \
    if ((++_sp & 255u) == 0u) { if (xb_ld(&(bar)[XB_TMO])) break; if (_sp > XB_SPIN_CAP) { atomicAdd(&(bar)[XB_TMO], 1u); break; } } } } while (0)
struct XcdBarrier { unsigned* bar; unsigned x; volatile LAS unsigned* st; };
__device__ __forceinline__ XcdBarrier xcd_barrier_post(unsigned* bar, volatile LAS unsigned* st) {
    XcdBarrier b; b.bar = bar; b.x = xb_xcc_id(); b.st = st;
    if (threadIdx.x == 0) (void)xb_add(&bar[XB_XCNT(b.x)], 1u);
    return b;
}
__device__ __forceinline__ void xcd_barrier_complete(unsigned* bar, unsigned x, unsigned& nloc, unsigned& nx) {
    const unsigned G = gridDim.x * gridDim.y * gridDim.z;
    unsigned sum, cnt, mine, sp = 0u;
    for (;;) {
        sum = 0u; cnt = 0u; mine = 0u;
#pragma unroll
        for (unsigned j = 0; j < 16; ++j) { const unsigned c = xb_ld(&bar[XB_XCNT(j)]); sum += c; cnt += (c > 0u) ? 1u : 0u; mine = (j == x) ? c : mine; }
        if (sum == G) break;
        __builtin_amdgcn_s_sleep(1);
        if ((++sp & 255u) == 0u) { if (xb_ld(&bar[XB_TMO])) break; if (sp > XB_SPIN_CAP) { atomicAdd(&bar[XB_TMO], 1u); break; } }
    }
    nloc = mine > 0u ? mine : 1u; nx = cnt > 0u ? cnt : 1u;
}
__device__ __forceinline__ void xcd_barrier(const XcdBarrier& b) {
    asm volatile("s_waitcnt vmcnt(0)" ::: "memory");
    __syncthreads();
    if (threadIdx.x == 0) {
        unsigned* bar = b.bar;
        __builtin_amdgcn_s_waitcnt(0);
        unsigned nloc = b.st[0], nx = b.st[1];
        if (nloc == 0u) { xcd_barrier_complete(bar, b.x, nloc, nx); b.st[0] = nloc; b.st[1] = nx; }
        const unsigned old = xb_add(&bar[XB_XSUB(b.x)], 1u);
        const unsigned gen = old / nloc;
        if (old + 1u == (gen + 1u) * nloc) {
            __builtin_amdgcn_fence(__ATOMIC_RELEASE, "agent");
            asm volatile("s_waitcnt vmcnt(0)" ::: "memory");
            const unsigned og = xb_add(&bar[XB_TOP], 1u);
            const unsigned tg = og / nx;
            if (og + 1u == (tg + 1u) * nx) xb_add(&bar[XB_TOPGEN], 1u);
            else XB_SPIN(xb_ld(&bar[XB_TOPGEN]) == tg, bar);
            __builtin_amdgcn_fence(__ATOMIC_ACQUIRE, "agent");
            xb_add(&bar[XB_XGEN(b.x)], 1u);
            asm volatile("s_waitcnt vmcnt(0)" ::: "memory");
        } else {
            XB_SPIN(xb_ld(&bar[XB_XGEN(b.x)]) == gen, bar);
            __builtin_amdgcn_fence(__ATOMIC_ACQUIRE, "agent");
            asm volatile("s_waitcnt vmcnt(0)" ::: "memory");
        }
    }
    __syncthreads();
}

namespace pg8 {
#define PG8_LAS __attribute__((address_space(3)))
typedef unsigned short bf16_t;
typedef short bf16x8 __attribute__((ext_vector_type(8)));
typedef float f32x4 __attribute__((ext_vector_type(4)));
typedef unsigned u32x4 __attribute__((ext_vector_type(4)));
constexpr int BM = 256, BK = 64, HALF = 128, HTB = HALF * BK * 2  , STAGE_BYTES = 8 * HTB, NXCD = 8, WGM = 8;

__host__ __device__ __forceinline__ int lds_byte(int r, int c) { const int st = (r >> 4) * 2 + (c >> 5), rr = r & 15, cc = c & 31, ob = rr * 64 + cc * 2; return st * 1024 + (ob ^ (((ob >> 9) & 1) << 5)); }
__host__ __device__ __forceinline__ void stage_rc(int b, int& R, int& C) { const int st = b / 1024, sb = b % 1024, swz = sb ^ (((sb >> 9) & 1) << 5); R = (st >> 1) * 16 + swz / 64; C = (st & 1) * 32 + (swz % 64) / 2; }
__host__ __device__ __forceinline__ int perm32(int rho) { const int n = rho >> 4, i = rho & 15; return 8 * (i >> 2) + 4 * n + (i & 3); }

struct Unit { int pm, pn; };
struct Gemm { const bf16_t* A; const bf16_t* Bt; int M, N, K; };

struct StaticOrder {
    int nM, nN, nwg, G, c;
    __host__ __device__ void init(int M, int N, int G_, int c_) { nM = M / BM; nN = N / BM; nwg = nM * nN; G = G_; c = c_; }
    __host__ __device__ bool next(int i, Unit& u) const {
        const long L = (long)i * G + c; if (L >= nwg) return false;
        int wgid = (int)L; { const int q = nwg / NXCD, r = nwg % NXCD, xcd = wgid % NXCD, off = wgid / NXCD; wgid = (xcd < r ? xcd * (q + 1) : r * (q + 1) + (xcd - r) * q) + off; }
        const int nig = WGM * nN, gid = wgid / nig, fm = gid * WGM, gsz = (nM - fm) < WGM ? (nM - fm) : WGM;
        u.pm = fm + ((wgid % nig) % gsz); u.pn = (wgid % nig) / gsz; return true;
    }
    __device__ __forceinline__ void a_ready(const Unit&) const {}
    __device__ __forceinline__ void done(const Unit&) const {}
};
__device__ __forceinline__ unsigned cvt_pk_bf16(float lo, float hi) { unsigned r; asm volatile("v_cvt_pk_bf16_f32 %0, %1, %2" : "=v"(r) : "v"(lo), "v"(hi)); return r; }
template <class Epi, class Sched, bool ALIGN_EPI = false, bool SP2 = false>
__device__ __forceinline__ void gemm_phase(PG8_LAS unsigned char* lds, const Gemm g, const Sched& S, const Epi& E) {
    int tid = threadIdx.x; asm volatile("" : "+v"(tid));
    const int wid = __builtin_amdgcn_readfirstlane(tid >> 6), lane = tid & 63, wr = wid >> 2, wc = wid & 3, fr = lane & 15, fq = lane >> 4;
    const int K = g.K, nt = K / BK;
    unsigned voffA[2], voffB[2];
#pragma unroll
    for (int i = 0; i < 2; ++i) { int R, C; stage_rc(tid * 16 + i * 8192, R, C); const int Rb = Epi::PERM ? ((R & ~31) + perm32(R & 31)) : R;
        voffA[i] = (unsigned)(R * K + C) * 2u; voffB[i] = (unsigned)(Rb * K + C) * 2u; }
    const size_t kstep = (size_t)(BK * 2);
    const size_t hstep = (size_t)HALF * K * 2;
    const size_t tstep = 2 * hstep;
    const unsigned ldsw = (unsigned)wid * 1024u;
    const int aoff = lds_byte(wr * 64 + fr, fq * 8), boff = lds_byte(wc * 32 + fr, fq * 8);
#define PG8_SA(b, h) (((b) * 2 + (h)) * HTB)
#define PG8_SB(b, h) ((4 + (b) * 2 + (h)) * HTB)
#define PG8_STAGE(bufoff, gbase, voff) do { _Pragma("unroll") for (int _i = 0; _i < 2; ++_i) \
        __builtin_amdgcn_global_load_lds((const unsigned*)((const char*)(gbase) + (voff)[_i]), (PG8_LAS unsigned*)(lds + (bufoff) + ldsw + _i * 8192), 16, 0, 0); } while (0)
#define PG8_LDA(dst, b, h) do { _Pragma("unroll") for (int m = 0; m < 4; ++m) _Pragma("unroll") for (int k = 0; k < 2; ++k) dst[m][k] = *(const PG8_LAS bf16x8*)(lds + PG8_SA(b, h) + aoff + m * 2048 + k * 1024); } while (0)
#define PG8_LDB(dst, b, h) do { _Pragma("unroll") for (int n = 0; n < 2; ++n) _Pragma("unroll") for (int k = 0; k < 2; ++k) dst[n][k] = *(const PG8_LAS bf16x8*)(lds + PG8_SB(b, h) + boff + n * 2048 + k * 1024); } while (0)
#define PG8_MMA(ai, bj, At, Bt) do { __builtin_amdgcn_s_setprio(1); _Pragma("unroll") for (int m = 0; m < 4; ++m) _Pragma("unroll") for (int n = 0; n < 2; ++n) _Pragma("unroll") for (int k = 0; k < 2; ++k) \
        acc[ai][bj][m][n] = __builtin_amdgcn_mfma_f32_16x16x32_bf16(Bt[n][k], At[m][k], acc[ai][bj][m][n], 0, 0, 0); __builtin_amdgcn_s_setprio(0); } while (0)
#define PG8_WAIT_V(n) asm volatile("s_waitcnt vmcnt(" #n ")" ::: "memory")
#define PG8_WAIT_L(n) asm volatile("s_waitcnt lgkmcnt(" #n ")" ::: "memory")
#define PG8_BAR __builtin_amdgcn_s_barrier()
#define PG8_SCHED __builtin_amdgcn_sched_barrier(0)
    Unit cur, nxt; int ui = 0;
    if (!S.next(0, cur)) return;
    f32x4 acc[2][2][4][2];
#pragma unroll
    for (int a = 0; a < 2; ++a)
#pragma unroll
        for (int b = 0; b < 2; ++b)
#pragma unroll
            for (int m = 0; m < 4; ++m)
#pragma unroll
                for (int n = 0; n < 2; ++n) acc[a][b][m][n] = (f32x4){0.f, 0.f, 0.f, 0.f};
    bf16x8 At[4][2], B0[2][2], B1[2][2];
    const char* cA = (const char*)g.A + (size_t)cur.pm * tstep; const char* cB = (const char*)g.Bt + (size_t)cur.pn * tstep;
    S.a_ready(cur);
    if constexpr (SP2) {
        PG8_STAGE(PG8_SB(0, 0), cB, voffB); PG8_STAGE(PG8_SB(0, 1), cB + hstep, voffB); PG8_STAGE(PG8_SA(0, 0), cA, voffA); PG8_STAGE(PG8_SA(0, 1), cA + hstep, voffA);
        if (wr == 1) PG8_BAR;
        PG8_WAIT_V(2); PG8_BAR;
        PG8_STAGE(PG8_SB(1, 0), cB + kstep, voffB); PG8_STAGE(PG8_SA(1, 0), cA + kstep, voffA); PG8_STAGE(PG8_SB(1, 1), cB + hstep + kstep, voffB);
        PG8_WAIT_V(6); PG8_BAR;
    } else {
        PG8_STAGE(PG8_SB(0, 0), cB, voffB); PG8_STAGE(PG8_SA(0, 0), cA, voffA); PG8_STAGE(PG8_SB(0, 1), cB + hstep, voffB); PG8_STAGE(PG8_SA(0, 1), cA + hstep, voffA);
        if (wr == 1) PG8_BAR;
        PG8_WAIT_V(4); PG8_BAR;
        PG8_STAGE(PG8_SB(1, 0), cB + kstep, voffB); PG8_STAGE(PG8_SA(1, 0), cA + kstep, voffA); PG8_STAGE(PG8_SB(1, 1), cB + hstep + kstep, voffB);
        PG8_WAIT_V(6); PG8_BAR;
    }
    for (;;) {
        const bool has_next = S.next(ui + 1, nxt);
        const char* nA = has_next ? (const char*)g.A + (size_t)nxt.pm * tstep : cA; const char* nB = has_next ? (const char*)g.Bt + (size_t)nxt.pn * tstep : cB;
        for (int t = 0; t < nt; t += 2) {
            const bool last = (t == nt - 2);
            const char* a1 = cA + (size_t)(t + 1) * kstep;
            const char* a2 = last ? nA : cA + (size_t)(t + 2) * kstep; const char* b2 = last ? nB : cB + (size_t)(t + 2) * kstep;
            const char* a3 = a2 + kstep; const char* b3 = b2 + kstep;
            if (last && has_next) S.a_ready(nxt);
            if constexpr (SP2) {
            PG8_LDB(B0, 0, 0); PG8_LDB(B1, 0, 1); PG8_SCHED; PG8_LDA(At, 0, 0); PG8_STAGE(PG8_SA(1, 1), a1 + hstep, voffA);
            PG8_WAIT_V(8); PG8_WAIT_L(0); PG8_BAR; PG8_MMA(0, 0, At, B0); PG8_MMA(0, 1, At, B1); PG8_BAR; PG8_SCHED;
            PG8_LDA(At, 0, 1); PG8_STAGE(PG8_SB(0, 0), b2, voffB); PG8_STAGE(PG8_SB(0, 1), b2 + hstep, voffB); PG8_STAGE(PG8_SA(0, 0), a2, voffA);
            PG8_WAIT_V(8); PG8_WAIT_L(0); PG8_BAR; PG8_MMA(1, 0, At, B0); PG8_MMA(1, 1, At, B1); PG8_BAR; PG8_SCHED;
            PG8_LDB(B0, 1, 0); PG8_LDB(B1, 1, 1); PG8_SCHED; PG8_LDA(At, 1, 0); PG8_STAGE(PG8_SA(0, 1), a2 + hstep, voffA);
            PG8_WAIT_V(8); PG8_WAIT_L(0); PG8_BAR; PG8_MMA(0, 0, At, B0); PG8_MMA(0, 1, At, B1); PG8_BAR; PG8_SCHED;
            PG8_LDA(At, 1, 1); PG8_STAGE(PG8_SB(1, 0), b3, voffB); PG8_STAGE(PG8_SB(1, 1), b3 + hstep, voffB); PG8_STAGE(PG8_SA(1, 0), a3, voffA);
            PG8_WAIT_V(8); PG8_WAIT_L(0); PG8_BAR; PG8_MMA(1, 0, At, B0); PG8_MMA(1, 1, At, B1); PG8_BAR; PG8_SCHED;
            } else {
            PG8_LDB(B0, 0, 0); PG8_SCHED; PG8_LDA(At, 0, 0); PG8_STAGE(PG8_SA(1, 1), a1 + hstep, voffA);
            PG8_WAIT_L(8); PG8_BAR; PG8_WAIT_L(0); PG8_MMA(0, 0, At, B0); PG8_BAR; PG8_SCHED;
            PG8_LDB(B1, 0, 1); PG8_STAGE(PG8_SB(0, 0), b2, voffB);
            PG8_BAR; PG8_WAIT_L(0); PG8_MMA(0, 1, At, B1); PG8_BAR;
            PG8_LDA(At, 0, 1); PG8_STAGE(PG8_SA(0, 0), a2, voffA);
            PG8_BAR; PG8_WAIT_L(0); PG8_MMA(1, 0, At, B0); PG8_BAR; PG8_SCHED;
            PG8_STAGE(PG8_SB(0, 1), b2 + hstep, voffB);
            PG8_WAIT_V(6); PG8_BAR; PG8_MMA(1, 1, At, B1); PG8_BAR;
            PG8_LDB(B0, 1, 0); PG8_SCHED; PG8_LDA(At, 1, 0); PG8_STAGE(PG8_SA(0, 1), a2 + hstep, voffA);
            PG8_WAIT_L(8); PG8_BAR; PG8_WAIT_L(0); PG8_MMA(0, 0, At, B0); PG8_BAR; PG8_SCHED;
            PG8_LDB(B1, 1, 1); PG8_STAGE(PG8_SB(1, 0), b3, voffB);
            PG8_BAR; PG8_WAIT_L(0); PG8_MMA(0, 1, At, B1); PG8_BAR;
            PG8_LDA(At, 1, 1); PG8_STAGE(PG8_SA(1, 0), a3, voffA);
            PG8_BAR; PG8_WAIT_L(0); PG8_MMA(1, 0, At, B0); PG8_BAR; PG8_SCHED;
            PG8_STAGE(PG8_SB(1, 1), b3 + hstep, voffB);
            PG8_WAIT_V(6); PG8_BAR; PG8_MMA(1, 1, At, B1); PG8_BAR;
            }
        }
        if constexpr (ALIGN_EPI) { if (wr == 0) PG8_BAR; }
        if constexpr (!Epi::AFTER_DRAIN) { E(acc, cur, wr, wc, fr, fq); S.done(cur); }
        if (!has_next) break;
#pragma unroll
        for (int a = 0; a < 2; ++a)
#pragma unroll
            for (int b = 0; b < 2; ++b)
#pragma unroll
                for (int m = 0; m < 4; ++m)
#pragma unroll
                    for (int n = 0; n < 2; ++n) acc[a][b][m][n] = (f32x4){0.f, 0.f, 0.f, 0.f};
        cur = nxt; cA = nA; cB = nB; ++ui;
        if constexpr (ALIGN_EPI) { if (wr == 1) PG8_BAR; }
    }
    PG8_WAIT_V(0);
    if constexpr (!ALIGN_EPI) { if (wr == 0) PG8_BAR; }
    PG8_BAR;
    if constexpr (Epi::AFTER_DRAIN) { E.fused(acc, cur, wr, wc, fr, fq, lds, wid, lane); S.done(cur); }
#undef PG8_SA
#undef PG8_SB
#undef PG8_STAGE
#undef PG8_LDA
#undef PG8_LDB
#undef PG8_MMA
#undef PG8_WAIT_V
#undef PG8_WAIT_L
#undef PG8_BAR
#undef PG8_SCHED
}
}

typedef short bf16x8 __attribute__((ext_vector_type(8)));
typedef float f32x4 __attribute__((ext_vector_type(4)));
typedef unsigned u32x4 __attribute__((ext_vector_type(4)));
typedef unsigned u32x2 __attribute__((ext_vector_type(2)));
constexpr int NTHREADS = 512, NWAVES = 8, LDS_BYTES = 147456;
constexpr int REP_P0 = 1, REP_P1 = 1, REP_P2 = 1, REP_P3 = 1, REP_P4 = 1;
#endif
#ifdef HOST_EMU
#define DEV static inline
#define LDSQ
#define TIDX emu_tid()
#define BIDX emu_bid()
#define GDIM emu_gdim()
#define SYNCTHREADS() emu_syncthreads()
#define WAVE_SYNC() emu_wave_sync()
#define MFMA16(a, b, c) emu_mfma16(a, b, c)
#define SHFL_XOR(v, m) emu_shfl_xor(v, m)
#define BALLOT(p) emu_ballot(p)
#define EXP2F(x) exp2f(x)
#define LDS_ATOMIC_ADD(ptr, v) (*(ptr) += (v))
#define FETCH_ADD_U32(ptr, v) __atomic_fetch_add(ptr, v, __ATOMIC_RELAXED)
#define XCC_ID() (emu_bid() % 8)
static inline unsigned f_as_u(float f) { union { unsigned u; float f; } c; c.f = f; return c.u; }
static inline unsigned cvtpk(float lo, float hi) { return (unsigned)f2bf(lo) | ((unsigned)f2bf(hi) << 16); }
#else
#define DEV __device__ __forceinline__
#define LDSQ LAS
__device__ __forceinline__ int opaque_tid() { int t = (int)threadIdx.x; asm volatile("" : "+v"(t)); return t; }
#define TIDX opaque_tid()
#define BIDX ((int)blockIdx.x)
#define GDIM ((int)gridDim.x)
#define SYNCTHREADS() __syncthreads()
#define WAVE_SYNC() asm volatile("s_waitcnt lgkmcnt(0)" ::: "memory")
#define MFMA16(a, b, c) __builtin_amdgcn_mfma_f32_16x16x32_bf16(a, b, c, 0, 0, 0)
#define SHFL_XOR(v, m) __shfl_xor(v, m)
#define BALLOT(p) __ballot(p)
#define EXP2F(x) __builtin_amdgcn_exp2f(x)
#define LDS_ATOMIC_ADD(ptr, v) atomicAdd((float*)(ptr), v)
#define FETCH_ADD_U32(ptr, v) __hip_atomic_fetch_add(ptr, v, __ATOMIC_RELAXED, __HIP_MEMORY_SCOPE_AGENT)
#define XCC_ID() ((int)xb_xcc_id())
__device__ __forceinline__ unsigned f_as_u(float f) { return __float_as_uint(f); }
__device__ __forceinline__ unsigned cvtpk(float lo, float hi) { unsigned r; asm("v_cvt_pk_bf16_f32 %0, %1, %2" : "=v"(r) : "v"(lo), "v"(hi)); return r; }
#endif

constexpr float LOG2E = 1.4426950408889634f, NEGF = -1e30f;
constexpr int NTH = 512, NWV = 8;
constexpr int A_STAGE = 0, A_STAGE_BYTES = 16384;
constexpr int A_IMP = 49152;
constexpr int A_BIAS = 81920;
constexpr int A_SELM = A_BIAS + 4352;
constexpr int A_MISC = A_SELM + 1024;
constexpr int A_END = A_MISC + 64;
HD int perm32k(int kk) { return (kk & 3) + 4 * ((kk >> 4) & 1) + 8 * ((kk >> 2) & 3); }

constexpr int HS_STRIDE = 272;
DEV void p2_compress_unit(const Params& p, LDSQ unsigned char* lds, int u) {
    const int tid = TIDX, lane = tid & 63, wave = tid >> 6, fr = lane & 15, fq = lane >> 4;
    constexpr int NCT = NCP / 32;
    const int ct = u % NCT, bg = (u / NCT) % (NB * NG), w = u / (NCT * NB * NG), c0 = 32 * ct;
    const bf16* src = p.kv[0] + (size_t)w * KVSZ + (size_t)bg * S * 64;
    const bf16* w1 = p.w1t[0] + (size_t)w * (128 * 2048);
    f32x4 acc[2] = {{0.f, 0.f, 0.f, 0.f}, {0.f, 0.f, 0.f, 0.f}};
    const bf16* a0 = src + (size_t)(c0 + fr) * 1024 + 8 * fq, *a1 = a0 + 16 * 1024, *bp = w1 + (size_t)(16 * wave + fr) * 2048 + 8 * fq;
#pragma unroll 8
    for (int ks = 0; ks < 64; ++ks) {
        const bf16x8 fa0 = *(const bf16x8*)(a0 + 32 * ks), fa1 = *(const bf16x8*)(a1 + 32 * ks), fb = *(const bf16x8*)(bp + 32 * ks);
        acc[0] = MFMA16(fa0, fb, acc[0]); acc[1] = MFMA16(fa1, fb, acc[1]);
    }
    const float pb = p.peb[0][w * 128 + 16 * wave + fr];
#pragma unroll
    for (int mt = 0; mt < 2; ++mt)
#pragma unroll
        for (int r = 0; r < 4; ++r) *(LDSQ bf16*)(lds + (16 * mt + 4 * fq + r) * HS_STRIDE + (16 * wave + fr) * 2) = f2bf(siluf(acc[mt][r] + pb));
    SYNCTHREADS();
    {
        const int mt = wave & 1, dt = wave >> 1; const bf16* w2 = p.w2t[0] + (size_t)w * (64 * 128) + (size_t)(16 * dt + fr) * 128 + 8 * fq;
        f32x4 o = {0.f, 0.f, 0.f, 0.f};
#pragma unroll
        for (int ks = 0; ks < 4; ++ks) { const bf16x8 fa = *(LDSQ const bf16x8*)(lds + (16 * mt + fr) * HS_STRIDE + (32 * ks + 8 * fq) * 2), fb = *(const bf16x8*)(w2 + 32 * ks); o = MFMA16(fa, fb, o); }
        const int d = 16 * dt + fr, cb = c0 + 16 * mt + 4 * fq;
        if (w == 0) {
#pragma unroll
            for (int r = 0; r < 4; ++r) p.kcvc[0][((size_t)bg * NCP + cb + r) * 64 + d] = (cb + r == NCP - 1) ? (bf16)0 : f2bf(o[r]);
        } else {
            u32x2 pk; pk[0] = cvtpk(o[0], o[1]); pk[1] = cvtpk(o[2], (cb + 3 == NCP - 1) ? 0.f : o[3]);
            *(u32x2*)(p.vct + (((size_t)bg * (NCP / 64) + (cb >> 6)) * 64 + d) * 64 + (cb & 32) + perm32k(cb & 31)) = pk;
        }
    }
    SYNCTHREADS();
}
constexpr int TS = 72;
DEV void p2_transpose_item(const Params& p, LDSQ unsigned char* lds, int it) {
    const int tid = TIDX, lane = tid & 63, wave = tid >> 6;
    const int nb = it % NSEL, bg = (it / NSEL) % (NB * NG), ten = it / (NSEL * NB * NG);
    const bf16* src = p.kv[0] + (size_t)(ten ? 5 : 3) * KVSZ + ((size_t)bg * S + 64 * nb) * 64;
    bf16* dst = (ten ? p.vtw : p.vts) + ((size_t)bg * NSEL + nb) * 4096;
    LDSQ bf16* tb = (LDSQ bf16*)(lds + wave * (64 * TS * 2));
#pragma unroll
    for (int i = 0; i < 8; ++i) { const int row = 8 * i + (lane >> 3), ch = lane & 7; const bf16x8 v = *(const bf16x8*)(src + row * 64 + ch * 8);
        const int pr = (row & 32) + perm32k(row & 31);
#pragma unroll
        for (int j = 0; j < 8; ++j) tb[(ch * 8 + j) * TS + pr] = (bf16)v[j]; }
    WAVE_SYNC();
#pragma unroll
    for (int i = 0; i < 8; ++i) { const int d = 8 * i + (lane >> 3), ch = lane & 7; *(bf16x8*)(dst + d * 64 + ch * 8) = *(LDSQ const bf16x8*)(tb + d * TS + ch * 8); }
    WAVE_SYNC();
}
DEV void p2_conv_item(const Params& p, long it) {
    const long row = it >> 6; const int c8 = (int)(it & 63) * 8, t = (int)(row % S);
    const bf16* hb = p.reg5[0] + R5SZ, *bb = hb + R5SZ, *cb = bb + R5SZ, *zb = cb + R5SZ;
    float y[8];
#pragma unroll
    for (int j = 0; j < 8; ++j) y[j] = 0.f;
#pragma unroll
    for (int k = 0; k < 3; ++k) { if (t - 2 + k < 0) continue; const size_t o = (size_t)(row - 2 + k) * 512 + c8;
        const bf16x8 h8 = *(const bf16x8*)(hb + o), cc8 = *(const bf16x8*)(cb + o); const f32x4 w0 = *(const f32x4*)(p.conv_w + k * 512 + c8), w1 = *(const f32x4*)(p.conv_w + k * 512 + c8 + 4);
#pragma unroll
        for (int j = 0; j < 8; ++j) y[j] += (j < 4 ? w0[j & 3] : w1[j & 3]) * (bf2f((bf16)cc8[j]) * bf2f((bf16)h8[j])); }
    const bf16x8 b8 = *(const bf16x8*)(bb + (size_t)row * 512 + c8), z8 = *(const bf16x8*)(zb + (size_t)row * 512 + c8);
    u32x4 o;
#pragma unroll
    for (int j = 0; j < 4; ++j) o[j] = cvtpk(bf2f((bf16)b8[2 * j]) * y[2 * j] * siluf(bf2f((bf16)z8[2 * j])), bf2f((bf16)b8[2 * j + 1]) * y[2 * j + 1] * siluf(bf2f((bf16)z8[2 * j + 1])));
    *(u32x4*)(p.mixed + (size_t)row * 1024 + 512 + c8) = o;
}
DEV void p2_phase(const Params& p, LDSQ unsigned char* lds) {
    const int tid = TIDX, wave = tid >> 6;
    constexpr int NCU = 2 * NB * NG * (NCP / 32);
    for (int u = BIDX; u < NCU; u += GDIM) p2_compress_unit(p, lds, u);
    const int gw = BIDX * NWV + wave, NGW = GDIM * NWV;
    for (int it = NGW - 1 - gw; it < 2 * NB * NG * NSEL; it += NGW) p2_transpose_item(p, lds, it);
    const long T = (long)GDIM * NTH;
    for (long it = (long)(GDIM - 1 - BIDX) * NTH + tid; it < (long)ROWS * 64; it += T) p2_conv_item(p, it);
}

#ifdef HOST_EMU
static inline float xmax16(float v) { return fmaxf(v, emu_shfl_xor(v, 16)); }
static inline float xmax32(float v) { return fmaxf(v, emu_shfl_xor(v, 32)); }
static inline float xsum16(float v) { return v + emu_shfl_xor(v, 16); }
static inline float xsum32(float v) { return v + emu_shfl_xor(v, 32); }
static inline float quad_sum(float v) { v += emu_shfl_xor(v, 1); v += emu_shfl_xor(v, 2); return v; }
#define SCHED_BARRIER()
#define WAVE_UNIFORM(x) (x)
#define OPAQUE_I(x)
#define OPAQUE_F(x)
#define GLDS16(gsrc, ldsdst, lane) memcpy((ldsdst) + 16 * (lane), (gsrc), 16)
#define VM_WAIT2()
#define VM_WAIT0()
#define BLOCK_BARRIER() emu_syncthreads()
#else
__device__ __forceinline__ float xmax16(float v) { const auto r = __builtin_amdgcn_permlane16_swap(__float_as_uint(v), __float_as_uint(v), false, false); return fmaxf(__uint_as_float(r[0]), __uint_as_float(r[1])); }
__device__ __forceinline__ float xmax32(float v) { const auto r = __builtin_amdgcn_permlane32_swap(__float_as_uint(v), __float_as_uint(v), false, false); return fmaxf(__uint_as_float(r[0]), __uint_as_float(r[1])); }
__device__ __forceinline__ float xsum16(float v) { const auto r = __builtin_amdgcn_permlane16_swap(__float_as_uint(v), __float_as_uint(v), false, false); return __uint_as_float(r[0]) + __uint_as_float(r[1]); }
__device__ __forceinline__ float xsum32(float v) { const auto r = __builtin_amdgcn_permlane32_swap(__float_as_uint(v), __float_as_uint(v), false, false); return __uint_as_float(r[0]) + __uint_as_float(r[1]); }
__device__ __forceinline__ float quad_sum(float v) {
    v += __int_as_float(__builtin_amdgcn_update_dpp(0, __float_as_int(v), 0xB1, 0xf, 0xf, true));
    v += __int_as_float(__builtin_amdgcn_update_dpp(0, __float_as_int(v), 0x4E, 0xf, 0xf, true));
    return v; }
#define SCHED_BARRIER() __builtin_amdgcn_sched_barrier(0)
#define WAVE_UNIFORM(x) __builtin_amdgcn_readfirstlane(x)
#define OPAQUE_I(x) asm volatile("" : "+v"(x))
#define OPAQUE_F(x) asm volatile("" : "+v"(x))
__device__ __forceinline__ void glds16_asm(const void* gsrc, unsigned lds_dst) { unsigned keep;
    asm volatile("s_mov_b32 %0, m0\n\ts_mov_b32 m0, %2\n\ts_nop 0\n\tglobal_load_lds_dwordx4 %1, off\n\ts_mov_b32 m0, %0" : "=&s"(keep) : "v"(gsrc), "s"(lds_dst) : "memory"); }
#define GLDS16(gsrc, ldsdst, lane) glds16_asm((const void*)(gsrc), (unsigned)__builtin_amdgcn_readfirstlane((int)(unsigned)(unsigned long)(ldsdst)))
#define VM_WAIT2() asm volatile("s_waitcnt vmcnt(2)" ::: "memory")
#define VM_WAIT0() asm volatile("s_waitcnt vmcnt(0)" ::: "memory")
#define BLOCK_BARRIER() do { asm volatile("s_waitcnt lgkmcnt(0)" ::: "memory"); __builtin_amdgcn_s_barrier(); asm volatile("" ::: "memory"); } while (0)
#endif
DEV void ld_frags(bf16x8 (&f)[8], LDSQ const unsigned char* img, int fr, int fq) {
    LDSQ const unsigned char* b0 = img + fr * 128 + ((fq ^ (fr & 7)) << 4); LDSQ const unsigned char* b1 = img + fr * 128 + (((4 + fq) ^ (fr & 7)) << 4);
#pragma unroll
    for (int t = 0; t < 4; ++t) { f[2 * t] = *(LDSQ const bf16x8*)(b0 + t * 2048); f[2 * t + 1] = *(LDSQ const bf16x8*)(b1 + t * 2048); }
}
DEV void qk2(const bf16x8 (&kf)[8], const bf16x8 (&qf)[2], f32x4 (&s)[4], float init) {
#pragma unroll
    for (int kt = 0; kt < 4; ++kt) { f32x4 a = {init, init, init, init}; a = MFMA16(kf[2 * kt], qf[0], a); a = MFMA16(kf[2 * kt + 1], qf[1], a); s[kt] = a; }
}
DEV void pv2(const bf16x8 (&vf)[8], const bf16x8 (&pb)[2], f32x4 (&o)[4]) {
#pragma unroll
    for (int dt = 0; dt < 4; ++dt) { o[dt] = MFMA16(vf[2 * dt], pb[0], o[dt]); o[dt] = MFMA16(vf[2 * dt + 1], pb[1], o[dt]); }
}
DEV void pack_p(const f32x4 (&pv)[4], bf16x8 (&pb)[2]) {
#pragma unroll
    for (int i = 0; i < 2; ++i) { u32x4 w; w[0] = cvtpk(pv[2 * i][0], pv[2 * i][1]); w[1] = cvtpk(pv[2 * i][2], pv[2 * i][3]); w[2] = cvtpk(pv[2 * i + 1][0], pv[2 * i + 1][1]); w[3] = cvtpk(pv[2 * i + 1][2], pv[2 * i + 1][3]); pb[i] = (bf16x8)w; }
}
DEV void bias_mask(f32x4 (&s)[4], LDSQ const float* btab, int tqe, int kstride, int dmax, int h, int fq) {
    OPAQUE_I(tqe); OPAQUE_I(fq);
    const int base = tqe - kstride * 4 * fq; LDSQ const float* bt = btab + h;
    float bv[16];
#pragma unroll
    for (int i = 0; i < 16; ++i) { const int dist = base - kstride * (16 * (i >> 2) + (i & 3)); int bi = dist < 0 ? 0 : dist; bi = bi > 128 ? 128 : bi; bv[i] = bt[bi * 8]; }
#pragma unroll
    for (int i = 0; i < 16; ++i) OPAQUE_F(bv[i]);
#pragma unroll
    for (int i = 0; i < 16; ++i) { const int dist = base - kstride * (16 * (i >> 2) + (i & 3)); s[i >> 2][i & 3] = ((unsigned)dist <= (unsigned)dmax) ? s[i >> 2][i & 3] + bv[i] : NEGF; }
}
DEV float tile_max(const f32x4 (&s)[4]) {
    float m = fmaxf(fmaxf(s[0][0], s[0][1]), fmaxf(s[0][2], s[0][3]));
#pragma unroll
    for (int kt = 1; kt < 4; ++kt) m = fmaxf(m, fmaxf(fmaxf(s[kt][0], s[kt][1]), fmaxf(s[kt][2], s[kt][3])));
    return xmax32(xmax16(m));
}
template <bool ELEM> DEV void softmax_step(f32x4 (&s)[4], float& m, float& l, f32x4 (&o)[4], bool colsel, bf16x8 (&pb)[2]) {
    float tmax = tile_max(s); if (!colsel) tmax = NEGF;
    const float mn = fmaxf(m, tmax), alpha = EXP2F(m - mn), mu = colsel ? mn : 1e30f; m = mn;
    float ps = 0.f;
#pragma unroll
    for (int kt = 0; kt < 4; ++kt)
#pragma unroll
        for (int r = 0; r < 4; ++r) { float e = EXP2F(s[kt][r] - mu); if (ELEM) e = s[kt][r] > -5e29f ? e : 0.f; s[kt][r] = e; ps += e; }
    l = l * alpha + ps;
#pragma unroll
    for (int dt = 0; dt < 4; ++dt) o[dt] = o[dt] * alpha;
    pack_p(s, pb);
}

DEV void attn_unit(const Params& p, LDSQ unsigned char* lds, int bg, int blk) {
    const int tid = TIDX, lane = tid & 63, wave = WAVE_UNIFORM(tid >> 6), fr = lane & 15, fq = lane >> 4;
    const int b = bg / NG, g = bg % NG, t0 = 64 * blk;
    const int r = fr & 3, h = 4 * g + r;
    LDSQ float* btab = (LDSQ float*)(lds + A_BIAS);
    LDSQ float* imp = (LDSQ float*)(lds + A_IMP);
    LDSQ unsigned long long* selm = (LDSQ unsigned long long*)(lds + A_SELM);
    int tq[2]; bf16x8 qf[2][2];
#pragma unroll
    for (int cg = 0; cg < 2; ++cg) { tq[cg] = t0 + 8 * wave + 4 * cg + (fr >> 2);
        const bf16* qp = p.q + (((size_t)b * NH + h) * S + tq[cg]) * 64 + 8 * fq; qf[cg][0] = *(const bf16x8*)qp; qf[cg][1] = *(const bf16x8*)(qp + 32); }
    for (int i = lane; i < 8 * 128; i += 64) imp[(8 * wave) * 128 + i] = 0.f;
    const int ncb = ((4 * blk + 2) >> 6) + 1, nslc = blk + 1, wb0 = blk > 8 ? blk - 8 : 0, nwin = blk - wb0 + 1, j_slc = 2 * ncb, j_win = j_slc + nslc, njobs = j_win + nwin;
    const bf16* kcb = p.kcvc[0] + (size_t)bg * NCP * 64; const bf16* vcb = p.vct + (size_t)bg * NCP * 64;
    const bf16* ksb = p.kv[0] + 2 * KVSZ + (size_t)bg * S * 64; const bf16* vsb = p.vts + (size_t)bg * S * 64;
    const bf16* kwb = p.kv[0] + 4 * KVSZ + (size_t)bg * S * 64; const bf16* vwb = p.vtw + (size_t)bg * S * 64;
    const int soff = ((tid >> 3) * 64 + (((tid & 7) ^ ((tid >> 3) & 7)) << 3));
#define STAGE_DMA(j) do { const int j_ = (j); const bf16* ks_; const bf16* vs_; \
        if (j_ < j_slc) { const int cb_ = j_ < ncb ? j_ : j_ - ncb; ks_ = kcb + (size_t)cb_ * 4096; vs_ = vcb + (size_t)cb_ * 4096; } \
        else if (j_ < j_win) { const int n_ = j_ - j_slc; ks_ = ksb + (size_t)n_ * 4096; vs_ = vsb + (size_t)n_ * 4096; } \
        else { const int n_ = wb0 + j_ - j_win; ks_ = kwb + (size_t)n_ * 4096; vs_ = vwb + (size_t)n_ * 4096; } \
        LDSQ unsigned char* sb_ = lds + A_STAGE + (j_ % 3) * A_STAGE_BYTES + wave * 1024; GLDS16(ks_ + soff, sb_, lane); GLDS16(vs_ + soff, sb_ + 8192, lane); } while (0)
    STAGE_DMA(0);
    if (njobs > 1) STAGE_DMA(1);
    if (njobs > 1) { VM_WAIT2(); } else { VM_WAIT0(); }
    BLOCK_BARRIER();
    float m[2] = {NEGF, NEGF}, l[2] = {0.f, 0.f};
    f32x4 o[2][4];
#pragma unroll
    for (int cg = 0; cg < 2; ++cg)
#pragma unroll
        for (int dt = 0; dt < 4; ++dt) o[cg][dt] = (f32x4){0.f, 0.f, 0.f, 0.f};
    const float bfar = btab[128 * 8 + h];
    for (int j = 0; j < njobs; ++j) {
        if (j + 2 < njobs) STAGE_DMA(j + 2);
        LDSQ const unsigned char* kimg = lds + A_STAGE + (j % 3) * A_STAGE_BYTES; LDSQ const unsigned char* vimg = kimg + 8192;
        bool drain = false;
        if (j < ncb) {
            bf16x8 kf[8]; ld_frags(kf, kimg, fr, fq);
#pragma unroll
            for (int cg = 0; cg < 2; ++cg) { f32x4 s[4]; qk2(kf, qf[cg], s, 0.f); bias_mask(s, btab, tq[cg] - 31 - 16 * 64 * j, 16, 1 << 30, h, fq);
                const float mn = fmaxf(m[cg], tile_max(s)), alpha = EXP2F(m[cg] - mn); m[cg] = mn; float ps = 0.f;
#pragma unroll
                for (int kt = 0; kt < 4; ++kt)
#pragma unroll
                    for (int rr = 0; rr < 4; ++rr) ps += s[kt][rr] > -5e29f ? EXP2F(s[kt][rr] - mn) : 0.f;
                l[cg] = l[cg] * alpha + ps; }
            if (j == ncb - 1) {
#pragma unroll
                for (int cg = 0; cg < 2; ++cg) l[cg] = 1.0f / fmaxf(xsum32(xsum16(l[cg])), 1e-30f);
            }
        } else if (j < j_slc) {
            const int cb = j - ncb;
#pragma unroll
            for (int cg = 0; cg < 2; ++cg) { f32x4 s[4]; bf16x8 pb[2];
                { bf16x8 kf[8]; ld_frags(kf, kimg, fr, fq); qk2(kf, qf[cg], s, 0.f); }
                bias_mask(s, btab, tq[cg] - 31 - 16 * 64 * cb, 16, 1 << 30, h, fq);
#pragma unroll
                for (int kt = 0; kt < 4; ++kt) {
#pragma unroll
                    for (int rr = 0; rr < 4; ++rr) s[kt][rr] = s[kt][rr] > -5e29f ? EXP2F(s[kt][rr] - m[cg]) * l[cg] : 0.f;
                    const float s4 = quad_sum((s[kt][0] + s[kt][1]) + (s[kt][2] + s[kt][3])), p3 = quad_sum(s[kt][3]);
                    if (r == 0) { int fq_ = fq; OPAQUE_I(fq_); const int n = 16 * cb + 4 * kt + fq_, ql = 8 * wave + 4 * cg + (fr >> 2); LDS_ATOMIC_ADD(&imp[ql * 128 + n], s4); if (n + 1 < NSEL) LDS_ATOMIC_ADD(&imp[ql * 128 + n + 1], p3); }
                }
                pack_p(s, pb);
                { bf16x8 vf[8]; ld_frags(vf, vimg, fr, fq); pv2(vf, pb, o[cg]); } }
            if (j == j_slc - 1) {
                drain = true;
#pragma unroll
                for (int cg = 0; cg < 2; ++cg) { m[cg] = NEGF; l[cg] = 0.f; int tq_ = tq[cg]; OPAQUE_I(tq_); const float g0_ = p.gates[((size_t)b * S + tq_) * 24 + h]; float* ap = p.attn_acc + ((size_t)b * S + tq_) * 512 + h * 64 + 4 * fq;
#pragma unroll
                    for (int dt = 0; dt < 4; ++dt) { *(f32x4*)(ap + 16 * dt) = o[cg][dt] * g0_; o[cg][dt] = (f32x4){0.f, 0.f, 0.f, 0.f}; } }
                WAVE_SYNC();
                int lane_ = lane; OPAQUE_I(lane_);
                for (int qq = 0; qq < 8; ++qq) { const int ql = 8 * wave + qq;
                    const int n0 = lane_, n1 = lane_ + 64; const float v0 = imp[ql * 128 + n0], v1 = imp[ql * 128 + n1];
                    const unsigned k0 = n0 > blk ? 0u : ((n0 == 0 || n0 == blk || n0 == blk - 1) ? 0xFFFFFFFFu : f_as_u(v0) + 1u);
                    const unsigned k1 = n1 > blk ? 0u : ((n1 == blk || n1 == blk - 1) ? 0xFFFFFFFFu : f_as_u(v1) + 1u);
                    unsigned T = 0u;
                    for (int bit = 31; bit >= 0; --bit) { const unsigned cand = T | (1u << bit); const int cnt = __builtin_popcountll(BALLOT(k0 >= cand)) + __builtin_popcountll(BALLOT(k1 >= cand)); if (cnt >= KTOP) T = cand; }
                    const bool g0b = k0 > T, g1b = k1 > T; const int need = KTOP - (__builtin_popcountll(BALLOT(g0b)) + __builtin_popcountll(BALLOT(g1b)));
                    const unsigned long long be0 = BALLOT(k0 == T), be1 = BALLOT(k1 == T), lt = (1ull << lane_) - 1ull;
                    const int r0 = __builtin_popcountll(be0 & lt), r1 = __builtin_popcountll(be0) + __builtin_popcountll(be1 & lt);
                    const unsigned long long sl0 = BALLOT((g0b || (k0 == T && r0 < need)) && n0 <= blk), sl1 = BALLOT((g1b || (k1 == T && r1 < need)) && n1 <= blk);
                    if (lane_ == 0) { selm[ql * 2] = sl0; selm[ql * 2 + 1] = sl1; } }
                WAVE_SYNC();
            }
        } else {
            const bool slc = j < j_win; const int n = slc ? j - j_slc : wb0 + j - j_win;
            const bool elem = (n + 2 >= blk) || (!slc && n + 8 == blk);
            bool cs0 = true, cs1 = true;
            if (slc) { int fr_ = fr; OPAQUE_I(fr_); const int qb = 8 * wave + (fr_ >> 2); cs0 = ((selm[qb * 2 + (n >> 6)] >> (n & 63)) & 1ull) != 0ull; cs1 = ((selm[(qb + 4) * 2 + (n >> 6)] >> (n & 63)) & 1ull) != 0ull; }
            const bool act0 = BALLOT(cs0) != 0ull, act1 = BALLOT(cs1) != 0ull;
            if (elem) {
                const int dmax = slc ? (1 << 30) : WIN - 1;
#pragma unroll
                for (int cg = 0; cg < 2; ++cg) { if (!(cg ? act1 : act0)) continue; f32x4 s[4]; bf16x8 pb[2];
                    { bf16x8 kf[8]; ld_frags(kf, kimg, fr, fq); qk2(kf, qf[cg], s, 0.f); }
                    bias_mask(s, btab, tq[cg] - 64 * n, 1, dmax, h, fq); softmax_step<true>(s, m[cg], l[cg], o[cg], cg ? cs1 : cs0, pb);
                    { bf16x8 vf[8]; ld_frags(vf, vimg, fr, fq); pv2(vf, pb, o[cg]); } }
            } else if (act0 || act1) {
                f32x4 s0[4], s1[4]; bf16x8 pb0[2], pb1[2];
                { bf16x8 kf[8]; ld_frags(kf, kimg, fr, fq);
                  if (act0) qk2(kf, qf[0], s0, bfar);
                  if (act1) qk2(kf, qf[1], s1, bfar); }
                bf16x8 vf[8]; ld_frags(vf, vimg, fr, fq);
                if (act0) softmax_step<false>(s0, m[0], l[0], o[0], cs0, pb0);
                if (act1) softmax_step<false>(s1, m[1], l[1], o[1], cs1, pb1);
                if (act0) pv2(vf, pb0, o[0]);
                if (act1) pv2(vf, pb1, o[1]);
            }
            if (j == j_win - 1) {
                drain = true;
#pragma unroll
                for (int cg = 0; cg < 2; ++cg) { int tq_ = tq[cg]; OPAQUE_I(tq_); const float sc = p.gates[((size_t)b * S + tq_) * 24 + 8 + h] / fmaxf(xsum32(xsum16(l[cg])), 1e-30f); m[cg] = NEGF; l[cg] = 0.f;
                    float* ap = p.attn_acc + ((size_t)b * S + tq_) * 512 + h * 64 + 4 * fq;
#pragma unroll
                    for (int dt = 0; dt < 4; ++dt) { *(f32x4*)(ap + 16 * dt) = *(const f32x4*)(ap + 16 * dt) + o[cg][dt] * sc; o[cg][dt] = (f32x4){0.f, 0.f, 0.f, 0.f}; } }
            }
        }
        if (j + 2 < njobs && !drain) { VM_WAIT2(); } else { VM_WAIT0(); }
        BLOCK_BARRIER();
    }
#undef STAGE_DMA
#pragma unroll
    for (int cg = 0; cg < 2; ++cg) { int tq_ = tq[cg]; OPAQUE_I(tq_); const size_t rowo = (size_t)b * S + tq_;
        const float sc = p.gates[rowo * 24 + 16 + h] / fmaxf(xsum32(xsum16(l[cg])), 1e-30f);
#pragma unroll
        for (int dt = 0; dt < 4; ++dt) { const int d0 = 16 * dt + 4 * fq; const f32x4 v = *(const f32x4*)(p.attn_acc + rowo * 512 + h * 64 + d0) + o[cg][dt] * sc;
            const u32x2 z = *(const u32x2*)(p.reg5[0] + rowo * 512 + h * 64 + d0);
            const float z0 = bf2f((bf16)(z[0] & 0xFFFFu)), z1 = bf2f((bf16)(z[0] >> 16)), z2 = bf2f((bf16)(z[1] & 0xFFFFu)), z3 = bf2f((bf16)(z[1] >> 16));
            u32x2 w; w[0] = cvtpk(v[0] * siluf(z0), v[1] * siluf(z1)); w[1] = cvtpk(v[2] * siluf(z2), v[3] * siluf(z3));
            *(u32x2*)(p.mixed + rowo * 1024 + h * 64 + d0) = w; } }
}
DEV void attn_phase(const Params& p, LDSQ unsigned char* lds, int rep = 0) {
    const int tid = TIDX;
    LDSQ float* btab = (LDSQ float*)(lds + A_BIAS);
    for (int i = tid; i < 129 * 8; i += NTH) btab[i] = p.bias_tab[i] * LOG2E;
    LDSQ int* misc = (LDSQ int*)(lds + A_MISC);
    constexpr int NQ = NB * NG;
    const int q0 = (XCC_ID() >> 1) % NQ;
    int qi = 0;
    for (;;) {
        SYNCTHREADS();
        if (tid == 0) { int u = NSEL, q = 0;
            while (qi < NQ) { q = (q0 + qi) % NQ; u = (int)FETCH_ADD_U32(p.ctr + 64 * (rep * NQ + q), 1u); if (u < NSEL) break; ++qi; }
            misc[0] = qi < NQ ? q : -1; misc[1] = NSEL - 1 - u; misc[2] = qi; }
        SYNCTHREADS();
        const int q = misc[0], blk = misc[1]; qi = misc[2]; if (q < 0) break;
        attn_unit(p, lds, q, blk);
    }
}
#ifndef HOST_EMU

__device__ __forceinline__ unsigned pk2(float lo, float hi) { return (unsigned)f2bf(lo) | ((unsigned)f2bf(hi) << 16); }
__device__ __forceinline__ float wave_sum(float v) {
#pragma unroll
    for (int o = 1; o < 64; o <<= 1) v += __shfl_xor(v, o);
    return v;
}
template <int MODE> __device__ __forceinline__ void p0_transpose_item(const Params& p, const float* W, int K, int N, int NPp, bf16* WT, LAS float* scr, int item, int lane) {
    const int nblk = NPp / 32, kb = item / nblk, nb = item % nblk, k0 = 64 * kb, n0 = 32 * nb;
    const int nn = n0 + (lane & 31); const int sc = MODE == 1 ? src_col(nn) : nn;
#pragma unroll 8
    for (int i = 0; i < 32; ++i) { const int kk = 2 * i + (lane >> 5); float v = 0.f;
        if (sc >= 0) { v = W[(size_t)(k0 + kk) * N + sc]; if (MODE == 1) v *= p.norm_w[k0 + kk]; }
        scr[kk * 33 + (lane & 31)] = v; }
    asm volatile("s_waitcnt lgkmcnt(0)" ::: "memory");
    const int c = lane & 7;
#pragma unroll
    for (int j = 0; j < 4; ++j) { const int n = (lane >> 3) + 8 * j; const LAS float* s = scr + (8 * c) * 33 + n;
        u32x4 o; o.x = pk2(s[0 * 33], s[1 * 33]); o.y = pk2(s[2 * 33], s[3 * 33]); o.z = pk2(s[4 * 33], s[5 * 33]); o.w = pk2(s[6 * 33], s[7 * 33]);
        *(u32x4*)(WT + (size_t)(n0 + n) * K + k0 + 8 * c) = o; }
    asm volatile("s_waitcnt lgkmcnt(0)" ::: "memory");
}
__device__ __forceinline__ void p0_prologue(const Params& p, LAS unsigned char* lds) {
    const int tid = threadIdx.x, lane = tid & 63, wave = tid >> 6;
    LAS float* scr = (LAS float*)(lds + wave * 16384);
    const int gw = blockIdx.x * NWAVES + wave, NGW = gridDim.x * NWAVES;
    constexpr int I_IN = (DM / 64) * (NP / 32), I_OUT = (DM / 64) * (DM / 32), I_W1 = (2048 / 64) * (128 / 32), I_W2 = (128 / 64) * (64 / 32);
    constexpr int NITEMS = I_IN + I_OUT + 2 * I_W1 + 2 * I_W2;
    for (int it = gw; it < NITEMS; it += NGW) {
        int r = it;
        if (r < I_IN) { p0_transpose_item<1>(p, p.w_in, DM, INCOLS, NP, p.wt_in, scr, r, lane); continue; } r -= I_IN;
        if (r < I_OUT) { p0_transpose_item<0>(p, p.w_out, DM, DM, DM, p.wt_out, scr, r, lane); continue; } r -= I_OUT;
        if (r < I_W1) { p0_transpose_item<0>(p, p.w_ck1, 2048, 128, 128, p.w1t[0], scr, r, lane); continue; } r -= I_W1;
        if (r < I_W1) { p0_transpose_item<0>(p, p.w_cv1, 2048, 128, 128, p.w1t[1], scr, r, lane); continue; } r -= I_W1;
        if (r < I_W2) { p0_transpose_item<0>(p, p.w_ck2, 128, 64, 64, p.w2t[0], scr, r, lane); continue; } r -= I_W2;
        p0_transpose_item<0>(p, p.w_cv2, 128, 64, 64, p.w2t[1], scr, r, lane);
    }
    for (int task = (NGW - 1 - gw); task < 256; task += NGW) { const int w = task >> 7, h = task & 127;
        const float* w1 = w ? p.w_cv1 : p.w_ck1; const float* pe = w ? p.pe_v : p.pe_k; float a = 0.f;
        for (int jd = lane; jd < 2048; jd += 64) a += pe[jd] * w1[(size_t)jd * 128 + h];
        a = wave_sum(a); if (lane == 0) p.peb[w][h] = a; }
    if (blockIdx.x == gridDim.x - 1) for (int i = tid; i < 129 * 8; i += NTHREADS) prep_bias_body(p, i);
    for (int m = gw; m < ROWS; m += NGW) {
        const f32x4* xr = (const f32x4*)(p.x + (size_t)m * DM) + lane; f32x4 v[4]; float s = 0.f;
#pragma unroll
        for (int j = 0; j < 4; ++j) { v[j] = xr[64 * j]; s += (v[j].x * v[j].x + v[j].y * v[j].y) + (v[j].z * v[j].z + v[j].w * v[j].w); }
        s = wave_sum(s);
        u32x2* o8 = (u32x2*)(p.xb + (size_t)m * DM) + lane;
#pragma unroll
        for (int j = 0; j < 4; ++j) { u32x2 w; w.x = pk2(v[j].x, v[j].y); w.y = pk2(v[j].z, v[j].w); o8[64 * j] = w; }
        if (lane == 0) p.rstd[m] = 1.0f / sqrtf(s * (1.0f / DM) + 1e-6f);
    }
}
struct EpiProj {
    static constexpr bool PERM = true, AFTER_DRAIN = false;
    const float* rstd; bf16* q; bf16* kv0; bf16* r50; float* gates;
    __device__ __forceinline__ void operator()(const f32x4 (&acc)[2][2][4][2], const pg8::Unit& u, int wr, int wc, int fr, int fq) const {
#pragma unroll
        for (int ai = 0; ai < 2; ++ai)
#pragma unroll
            for (int m = 0; m < 4; ++m) {
                const int row = u.pm * 256 + ai * 128 + wr * 64 + m * 16 + fr; const float rs = rstd[row]; const int b = row / S, s = row % S;
#pragma unroll
                for (int bj = 0; bj < 2; ++bj) {
                    const int col0 = u.pn * 256 + bj * 128 + wc * 32 + 8 * fq;
                    f32x4 v0 = acc[ai][bj][m][0] * rs, v1 = acc[ai][bj][m][1] * rs;
                    if (col0 >= 3840) {
                        if (col0 < 3864) { float* gp = gates + ((size_t)b * S + s) * 24 + (col0 - 3840);
                            *(f32x4*)gp = (f32x4){sigmf(v0[0]), sigmf(v0[1]), sigmf(v0[2]), sigmf(v0[3])}; *(f32x4*)(gp + 4) = (f32x4){sigmf(v1[0]), sigmf(v1[1]), sigmf(v1[2]), sigmf(v1[3])}; }
                        continue; }
                    bf16* dst;
                    if (col0 < 512) { v0 = v0 * QSCALE; v1 = v1 * QSCALE; dst = q + (((size_t)b * NH + (col0 >> 6)) * S + s) * 64 + (col0 & 63); }
                    else if (col0 < 1280) { const int j = (col0 - 512) >> 7, g = ((col0 - 512) >> 6) & 1; dst = kv0 + (size_t)j * KVSZ + (((size_t)b * NG + g) * S + s) * 64 + (col0 & 63); }
                    else { const int r = (col0 - 1280) >> 9, c = (col0 - 1280) & 511; dst = r50 + (size_t)r * R5SZ + ((size_t)b * S + s) * 512 + c; }
                    u32x4 w; w.x = pg8::cvt_pk_bf16(v0[0], v0[1]); w.y = pg8::cvt_pk_bf16(v0[2], v0[3]); w.z = pg8::cvt_pk_bf16(v1[0], v1[1]); w.w = pg8::cvt_pk_bf16(v1[2], v1[3]);
                    *(u32x4*)dst = w;
                }
            }
    }
};
struct EpiOut {
    static constexpr bool PERM = false, AFTER_DRAIN = false;
    const float* x; float* out; float* rowss;
    __device__ __forceinline__ void operator()(const f32x4 (&acc)[2][2][4][2], const pg8::Unit& u, int wr, int wc, int fr, int fq) const {
#pragma unroll
        for (int ai = 0; ai < 2; ++ai)
#pragma unroll
            for (int m = 0; m < 4; ++m) {
                const int row = u.pm * 256 + ai * 128 + wr * 64 + m * 16 + fr; float ss = 0.f;
#pragma unroll
                for (int bj = 0; bj < 2; ++bj)
#pragma unroll
                    for (int n = 0; n < 2; ++n) { const size_t off = (size_t)row * DM + u.pn * 256 + bj * 128 + wc * 32 + 16 * n + 4 * fq;
                        const f32x4 y = *(const f32x4*)(x + off) + acc[ai][bj][m][n]; *(f32x4*)(out + off) = y; ss += (y[0] * y[0] + y[1] * y[1]) + (y[2] * y[2] + y[3] * y[3]); }
                ss += __shfl_xor(ss, 16); ss += __shfl_xor(ss, 32);
                if (fq == 0) rowss[(size_t)row * 16 + u.pn * 4 + wc] = ss;
            }
    }
};
__device__ __forceinline__ void p4_final_norm(const Params& p) {
    const int tid = opaque_tid(), lane = tid & 63, wave = tid >> 6; const int gw = blockIdx.x * NWAVES + wave, NGW = gridDim.x * NWAVES;
    f32x4 w4[4];
#pragma unroll
    for (int j = 0; j < 4; ++j) w4[j] = *((const f32x4*)p.fnw + lane + 64 * j);
    for (int m = gw; m < ROWS; m += NGW) {
        float s = lane < 16 ? p.rowss[(size_t)m * 16 + lane] : 0.f;
        s += __shfl_xor(s, 1); s += __shfl_xor(s, 2); s += __shfl_xor(s, 4); s += __shfl_xor(s, 8); s = __shfl(s, 0);
        const float r = 1.0f / sqrtf(s * (1.0f / DM) + 1e-6f);
        f32x4* yr = (f32x4*)(p.out + (size_t)m * DM) + lane;
#pragma unroll
        for (int j = 0; j < 4; ++j) yr[64 * j] = yr[64 * j] * r * w4[j];
    }
}

__global__ void __launch_bounds__(NTHREADS, 2) mega_fwd(Params p) {
    extern __shared__ __attribute__((aligned(16))) unsigned char lds_raw[];
    LAS unsigned char* lds = (LAS unsigned char*)lds_raw;
    volatile LAS unsigned* st = (volatile LAS unsigned*)(lds + LDS_BYTES - 64);
    if (threadIdx.x < 16) st[threadIdx.x] = 0u;
    __syncthreads();
    const XcdBarrier bar = xcd_barrier_post(p.bar, st);
    const long T = (long)gridDim.x * NTHREADS, t0 = (long)blockIdx.x * NTHREADS + threadIdx.x;
#define SWEEP(name, n) for (long g_ = t0; g_ < (long)(n); g_ += T) name##_body(p, g_)
    for (int rep = 0; rep < REP_P0; ++rep) { p0_prologue(p, lds); xcd_barrier(bar); }
    for (int rep = 0; rep < REP_P1; ++rep) {
        pg8::Gemm g{p.xb, p.wt_in, ROWS, NP, DM}; pg8::StaticOrder so; so.init(ROWS, NP, (int)gridDim.x, (int)blockIdx.x);
        EpiProj E{p.rstd, p.q, p.kv[0], p.reg5[0], p.gates};
        pg8::gemm_phase<EpiProj, pg8::StaticOrder, true, true>(lds, g, so, E);
        xcd_barrier(bar);
    }
    for (int rep = 0; rep < REP_P2; ++rep) { p2_phase(p, lds); xcd_barrier(bar); }
    for (int rep = 0; rep < REP_P3; ++rep) { attn_phase(p, lds, rep); xcd_barrier(bar); }
    for (int rep = 0; rep < REP_P4; ++rep) {
        pg8::Gemm g{p.mixed, p.wt_out, ROWS, DM, DM}; pg8::StaticOrder so; so.init(ROWS, DM, (int)gridDim.x, (int)blockIdx.x);
        EpiOut E{p.x, p.out, p.rowss};
        pg8::gemm_phase<EpiOut, pg8::StaticOrder, true, true>(lds, g, so, E);
        if (rep + 1 < REP_P4) xcd_barrier(bar);
    }
    xcd_barrier(bar);
    p4_final_norm(p);
}

extern "C" void kernel_launch(void* const* d_in, const int* in_sizes, int n_in, void* d_out, int out_size, void* d_ws, size_t ws_size, hipStream_t stream) {
    static int grid = 0;
    if (grid == 0) {
        int dev = 0, cus = 0, per_cu = 0;
        if (hipGetDevice(&dev) != hipSuccess || hipDeviceGetAttribute(&cus, hipDeviceAttributeMultiprocessorCount, dev) != hipSuccess) { fprintf(stderr, "kernel_launch: device query failed\n"); grid = -1; return; }
        if (hipFuncSetAttribute((const void*)mega_fwd, hipFuncAttributeMaxDynamicSharedMemorySize, LDS_BYTES) != hipSuccess) { fprintf(stderr, "kernel_launch: hipFuncSetAttribute failed\n"); grid = -1; return; }
        if (hipOccupancyMaxActiveBlocksPerMultiprocessor(&per_cu, (const void*)mega_fwd, NTHREADS, LDS_BYTES) != hipSuccess || per_cu < 1) { fprintf(stderr, "kernel_launch: occupancy query says %d blocks per CU\n", per_cu); grid = -1; return; }
        (void)hipGetLastError();
        grid = cus;
    }
    if (grid < 0) return;
    Params p; memset(&p, 0, sizeof(p));
    const float** ins[13] = {&p.x, &p.norm_w, &p.w_in, &p.w_ck1, &p.w_ck2, &p.pe_k, &p.w_cv1, &p.w_cv2, &p.pe_v, &p.conv_w, &p.w_out, &p.rel_bias, &p.fnw};
    for (int i = 0; i < 13; ++i) *ins[i] = (const float*)d_in[i];
    p.out = (float*)d_out;
    const size_t need = carve(p, (char*)d_ws);
    if (need > ws_size) { fprintf(stderr, "workspace too small: need %zu have %zu\n", need, ws_size); return; }
    if (hipMemsetAsync(p.bar, 0, 16384, stream) != hipSuccess) { fprintf(stderr, "kernel_launch: memset failed\n"); return; }
    hipLaunchKernelGGL(mega_fwd, dim3(grid), dim3(NTHREADS), LDS_BYTES, stream, p);
}
#endif
```

```cpp
#ifndef HOST_EMU
#include <hip/hip_runtime.h>
#include <cstdio>
#include <cstdint>
#include <cstring>
#define HD __host__ __device__ __forceinline__
#else
#include <cmath>
#include <cstdio>
#include <cstdint>
#include <cstring>
#define HD static inline
#endif

#ifndef SEQ
#define SEQ 8192
#endif
typedef unsigned short bf16;
constexpr int NB = 2, S = SEQ, DM = 1024, NH = 8, HDIM = 64, NG = 2, NR = 4, DATT = 512, DCONV = 512;
constexpr int INCOLS = 3864, NP = 4096, NCMP = S / 16 - 1, NCP = S / 16, NSEL = S / 64, KTOP = (NSEL < 16 ? NSEL : 16);
constexpr int WIN = 512, ROWS = NB * S;
constexpr long KVSZ = (long)NB * NG * S * 64, R5SZ = (long)ROWS * 512;
constexpr float QSCALE = 0.125f * 1.4426950408889634f, INV_LOG2E = 0.6931471805599453f;

HD float bf2f(bf16 v) { union { unsigned u; float f; } c; c.u = ((unsigned)v) << 16; return c.f; }
HD bf16 f2bf(float f) { union { unsigned u; float f; } c; c.f = f; unsigned u = c.u; unsigned r = u + 0x7FFFu + ((u >> 16) & 1u); return (bf16)(r >> 16); }
HD float siluf(float v) { return v / (1.f + expf(-v)); }
HD float sigmf(float v) { return 1.f / (1.f + expf(-v)); }

struct Params {
    const float *x, *norm_w, *w_in, *w_ck1, *w_ck2, *pe_k, *w_cv1, *w_cv2, *pe_v, *conv_w, *w_out, *rel_bias, *fnw;
    float* out;
    unsigned* bar;
    bf16 *wt_in, *wt_out, *w1t[2], *w2t[2];
    float *peb[2], *bias_tab;
    bf16* xb; float* rstd;
    bf16 *q, *kv[6], *reg5[5];
    float* gates;
    float* hid;
    bf16* kcvc[2];
    float* imp; int* idx; float* attn_acc; bf16* mixed; float* rowss;
    bf16 *vts, *vtw, *vct; unsigned* ctr;
};

HD int t5_bucket(int d) {
    if (d >= 128) return 31;
    const unsigned long long lo = 0x81041088929fffeull, hi = 0x2000800802008ull;
    if (d < 64) return __builtin_popcountll(lo & ((2ull << d) - 1ull));
    return __builtin_popcountll(lo) + __builtin_popcountll(hi & ((2ull << (d - 64)) - 1ull));
}
HD int src_col(int n) { return n < 1280 ? n : (n < 3840 ? n + 24 : (n < 3864 ? 1280 + (n - 3840) : -1)); }
HD void prep_wtin_body(const Params& p, long gid) {
    const int n = (int)(gid / DM), k = (int)(gid % DM); const int c = src_col(n);
    p.wt_in[gid] = c < 0 ? (bf16)0 : f2bf(p.norm_w[k] * p.w_in[(long)k * INCOLS + c]);
}
HD void prep_wtout_body(const Params& p, long gid) {
    const int n = (int)(gid / DM), k = (int)(gid % DM);
    p.wt_out[gid] = f2bf(p.w_out[(long)k * DM + n]);
}
HD void prep_w1t_body(const Params& p, long gid) {
    const int w = (int)(gid / (128 * 2048)), r = (int)(gid % (128 * 2048)), h = r / 2048, jd = r % 2048;
    const float* w1 = w ? p.w_cv1 : p.w_ck1;
    p.w1t[w][r] = f2bf(w1[(long)jd * 128 + h]);
}
HD void prep_w2t_body(const Params& p, long gid) {
    const int w = (int)(gid / (64 * 128)), r = (int)(gid % (64 * 128)), d = r / 128, h = r % 128;
    const float* w2 = w ? p.w_cv2 : p.w_ck2;
    p.w2t[w][r] = f2bf(w2[h * 64 + d]);
}
HD void prep_peb_body(const Params& p, long gid) {
    const int w = (int)(gid / 128), h = (int)(gid % 128);
    const float* w1 = w ? p.w_cv1 : p.w_ck1; const float* pe = w ? p.pe_v : p.pe_k;
    float a = 0.f; for (int jd = 0; jd < 2048; ++jd) a += pe[jd] * w1[(long)jd * 128 + h];
    p.peb[w][h] = a;
}
HD void prep_bias_body(const Params& p, long gid) {
    const int d = (int)(gid / 8), h = (int)(gid % 8); const int bk = t5_bucket(d);
    p.bias_tab[gid] = p.rel_bias[bk * 8 + h];
}
HD void prep_x_body(const Params& p, long row) {
    const float* xr = p.x + row * DM; float ss = 0.f;
    for (int k = 0; k < DM; ++k) { const float v = xr[k]; ss += v * v; p.xb[row * DM + k] = f2bf(v); }
    p.rstd[row] = 1.0f / sqrtf(ss / DM + 1e-6f);
}
HD void store_proj(const Params& p, int row, int n, float v) {
    const int b = row / S, s = row % S;
    if (n < 512) { const int h = n >> 6, d = n & 63; p.q[(((long)b * NH + h) * S + s) * 64 + d] = f2bf(v * QSCALE); }
    else if (n < 1280) { const int j = (n - 512) >> 7, g = ((n - 512) >> 6) & 1, d = n & 63; p.kv[j][(((long)b * NG + g) * S + s) * 64 + d] = f2bf(v); }
    else if (n < 3840) { const int r = (n - 1280) >> 9, c = (n - 1280) & 511; p.reg5[r][((long)b * S + s) * 512 + c] = f2bf(v); }
    else if (n < 3864) { p.gates[((long)b * S + s) * 24 + (n - 3840)] = sigmf(v); }
}
HD void compress1_body(const Params& p, long gid) {
    const int h = (int)(gid % 128); long r = gid / 128; const int c = (int)(r % NCMP); r /= NCMP; const int g = (int)(r % NG); r /= NG; const int b = (int)(r % NB); const int w = (int)(r / NB);
    const bf16* src = p.kv[w] + (((long)b * NG + g) * S + 16 * c) * 64;
    const bf16* wr = p.w1t[w] + (long)h * 2048;
    float a = p.peb[w][h];
    for (int jd = 0; jd < 2048; ++jd) a += bf2f(src[jd]) * bf2f(wr[jd]);
    p.hid[((((long)w * NB + b) * NG + g) * NCP + c) * 128 + h] = a;
}
HD void compress2_body(const Params& p, long gid) {
    const int d = (int)(gid % 64); long r = gid / 64; const int c = (int)(r % NCMP); r /= NCMP; const int g = (int)(r % NG); r /= NG; const int b = (int)(r % NB); const int w = (int)(r / NB);
    const float* hp = p.hid + ((((long)w * NB + b) * NG + g) * NCP + c) * 128;
    const bf16* wr = p.w2t[w] + d * 128;
    float a = 0.f;
    for (int h = 0; h < 128; ++h) a += bf2f(f2bf(siluf(hp[h]))) * bf2f(wr[h]);
    p.kcvc[w][(((long)b * NG + g) * NCP + c) * 64 + d] = f2bf(a);
}
HD float dot64(const bf16* q, const bf16* k) { float a = 0.f;
#pragma unroll 8
    for (int d = 0; d < 64; ++d) a += bf2f(q[d]) * bf2f(k[d]);
    return a; }

HD void cmp_body(const Params& p, long gid) {
    const int t = (int)(gid % S); const int g = (int)((gid / S) % NG); const int b = (int)(gid / ((long)S * NG));
    const int nv = t >= 31 ? (t - 31) / 16 + 1 : 0;
    float* imp = p.imp + gid * 128;
    for (int n = 0; n < 128; ++n) imp[n] = 0.f;
    const bf16* kc = p.kcvc[0] + ((long)b * NG + g) * NCP * 64;
    const bf16* vc = p.kcvc[1] + ((long)b * NG + g) * NCP * 64;
    for (int r = 0; r < NR; ++r) {
        const int h = g * NR + r;
        const bf16* qp = p.q + (((long)b * NH + h) * S + t) * 64;
        const bf16* q = qp; float o[64];
#pragma unroll
        for (int d = 0; d < 64; ++d) o[d] = 0.f;
        float m = -1e30f;
        for (int c = 0; c < nv; ++c) { const int dist = t - (16 * c + 31); const float s = dot64(q, kc + c * 64) * INV_LOG2E + p.bias_tab[(dist < 128 ? dist : 128) * 8 + h]; m = fmaxf(m, s); }
        float l = 0.f;
        for (int c = 0; c < nv; ++c) { const int dist = t - (16 * c + 31); const float s = dot64(q, kc + c * 64) * INV_LOG2E + p.bias_tab[(dist < 128 ? dist : 128) * 8 + h]; l += expf(s - m); }
        const float inv = 1.f / fmaxf(l, 1e-30f);
        for (int c = 0; c < nv; ++c) {
            const int dist = t - (16 * c + 31); const float s = dot64(q, kc + c * 64) * INV_LOG2E + p.bias_tab[(dist < 128 ? dist : 128) * 8 + h];
            const float pr = expf(s - m) * inv;
#pragma unroll
            for (int d = 0; d < 64; ++d) o[d] += pr * bf2f(vc[c * 64 + d]);
            imp[c >> 2] += pr; if ((c & 3) == 3) imp[(c >> 2) + 1] += pr;
        }
        const float g0 = p.gates[((long)b * S + t) * 24 + 0 * 8 + h];
        float* ao = p.attn_acc + ((long)b * S + t) * 512 + h * 64;
#pragma unroll
        for (int d = 0; d < 64; ++d) ao[d] = g0 * o[d];
    }
    const int blk = t >> 6;
    for (int n = 0; n < NSEL; ++n) { const bool forced = (n == 0) || (n == blk) || (n == blk - 1); imp[n] = forced ? 1e3f : (n <= blk ? imp[n] : -1.0f); }
    int* idx = p.idx + gid * 16;
    for (int k = 0; k < KTOP; ++k) {
        float best = -3e38f; int bi = 0;
        for (int n = 0; n < NSEL; ++n) { const float v = imp[n]; if (v > best) { best = v; bi = n; } }
        idx[k] = bi; imp[bi] = -3.4e38f;
    }
}
HD void slcwin_body(const Params& p, long gid) {
    const int t = (int)(gid % S); const int h = (int)((gid / S) % NH); const int b = (int)(gid / ((long)S * NH)); const int g = h / NR;
    const bf16* qp = p.q + (((long)b * NH + h) * S + t) * 64;
    const bf16* q = qp; float o[64];
#pragma unroll
    for (int d = 0; d < 64; ++d) o[d] = 0.f;
    const long kvoff = ((long)b * NG + g) * S * 64;
    float* ai = p.attn_acc + ((long)b * S + t) * 512 + h * 64;
    {
        const bf16* K = p.kv[2] + kvoff; const bf16* V = p.kv[3] + kvoff;
        const int* idx = p.idx + (((long)b * NG + g) * S + t) * 16;
        float m = -1e30f, l = 0.f;
        for (int k = 0; k < KTOP; ++k) {
            const int n = idx[k];
            for (int j = 0; j < 64; ++j) {
                const int pos = n * 64 + j, dist = t - pos; if (dist < 0) continue;
                const float s = dot64(q, K + (long)pos * 64) * INV_LOG2E + p.bias_tab[(dist < 128 ? dist : 128) * 8 + h];
                if (s > m) { const float f = expf(m - s); l *= f;
#pragma unroll
                    for (int d = 0; d < 64; ++d) o[d] *= f;
                    m = s; }
                const float pr = expf(s - m); l += pr;
#pragma unroll
                for (int d = 0; d < 64; ++d) o[d] += pr * bf2f(V[(long)pos * 64 + d]);
            }
        }
        const float g1 = p.gates[((long)b * S + t) * 24 + 1 * 8 + h] / fmaxf(l, 1e-30f);
#pragma unroll
        for (int d = 0; d < 64; ++d) { ai[d] += g1 * o[d]; o[d] = 0.f; }
    }
    {
        const bf16* K = p.kv[4] + kvoff; const bf16* V = p.kv[5] + kvoff;
        float m = -1e30f, l = 0.f;
        const int lo = t - (WIN - 1) > 0 ? t - (WIN - 1) : 0;
        for (int pos = lo; pos <= t; ++pos) {
            const int dist = t - pos;
            const float s = dot64(q, K + (long)pos * 64) * INV_LOG2E + p.bias_tab[(dist < 128 ? dist : 128) * 8 + h];
            if (s > m) { const float f = expf(m - s); l *= f;
#pragma unroll
                for (int d = 0; d < 64; ++d) o[d] *= f;
                m = s; }
            const float pr = expf(s - m); l += pr;
#pragma unroll
            for (int d = 0; d < 64; ++d) o[d] += pr * bf2f(V[(long)pos * 64 + d]);
        }
        const float g2 = p.gates[((long)b * S + t) * 24 + 2 * 8 + h] / fmaxf(l, 1e-30f);
        const bf16* z = p.reg5[0] + ((long)b * S + t) * 512 + h * 64;
        bf16* mo = p.mixed + ((long)b * S + t) * 1024 + h * 64;
#pragma unroll
        for (int d = 0; d < 64; ++d) mo[d] = f2bf((ai[d] + g2 * o[d]) * siluf(bf2f(z[d])));
    }
}
HD void conv_body(const Params& p, long gid) {
    const int ch = (int)(gid % 512); const int t = (int)((gid / 512) % S); const int b = (int)(gid / (512L * S));
    const long base = ((long)b * S + t) * 512 + ch;
    float y = 0.f;
    for (int k = 0; k < 3; ++k) { const int tt = t - 2 + k; if (tt < 0) continue; const long o = base - (long)(2 - k) * 512;
        y += p.conv_w[k * 512 + ch] * (bf2f(p.reg5[3][o]) * bf2f(p.reg5[1][o])); }
    const float v = bf2f(p.reg5[2][base]) * y * siluf(bf2f(p.reg5[4][base]));
    p.mixed[((long)b * S + t) * 1024 + 512 + ch] = f2bf(v);
}
HD void final_norm_body(const Params& p, long row) {
    float* yr = p.out + row * DM; float ss = 0.f;
    for (int k = 0; k < DM; ++k) ss += yr[k] * yr[k];
    const float r = 1.0f / sqrtf(ss / DM + 1e-6f);
    for (int k = 0; k < DM; ++k) yr[k] = yr[k] * r * p.fnw[k];
}

static inline size_t carve(Params& p, char* base) {
    size_t off = 0; auto take = [&](size_t bytes) { char* r = base ? base + off : nullptr; off += (bytes + 255) & ~(size_t)255; return r; };
    p.bar = (unsigned*)take(16384);
    p.wt_in = (bf16*)take((size_t)NP * DM * 2); p.wt_out = (bf16*)take((size_t)DM * DM * 2);
    for (int w = 0; w < 2; ++w) p.w1t[w] = (bf16*)take(128 * 2048 * 2);
    for (int w = 0; w < 2; ++w) p.w2t[w] = (bf16*)take(64 * 128 * 2);
    for (int w = 0; w < 2; ++w) p.peb[w] = (float*)take(128 * 4);
    p.bias_tab = (float*)take(129 * 8 * 4);
    p.xb = (bf16*)take((size_t)ROWS * DM * 2); p.attn_acc = (float*)p.xb;
    p.rstd = (float*)take((size_t)ROWS * 4);
    p.q = (bf16*)take((size_t)NB * NH * S * 64 * 2);
    for (int j = 0; j < 6; ++j) p.kv[j] = (bf16*)take((size_t)NB * NG * S * 64 * 2);
    for (int j = 0; j < 5; ++j) p.reg5[j] = (bf16*)take((size_t)ROWS * 512 * 2);
    p.gates = (float*)take((size_t)ROWS * 24 * 4);
    p.hid = (float*)take((size_t)2 * NB * NG * NCP * 128 * 4);
    for (int w = 0; w < 2; ++w) p.kcvc[w] = (bf16*)take((size_t)NB * NG * NCP * 64 * 2);
    p.imp = (float*)take((size_t)NB * NG * S * 128 * 4);
    p.idx = (int*)take((size_t)NB * NG * S * 16 * 4);
    p.mixed = (bf16*)take((size_t)ROWS * 1024 * 2);
    p.rowss = (float*)take((size_t)ROWS * 16 * 4);
    p.vts = (bf16*)take((size_t)KVSZ * 2); p.vtw = (bf16*)take((size_t)KVSZ * 2); p.vct = (bf16*)take((size_t)NB * NG * 64 * NCP * 2);
    p.ctr = p.bar + 3584;
    return off;
}

#ifndef HOST_EMU
#define LAS __attribute__((address_space(3)))
#define XB_TMO      128
#define XB_XCNT(j)  (256  + 64 * (j))
#define XB_XSUB(j)  (1280 + 64 * (j))
#define XB_XGEN(j)  (2304 + 64 * (j))
#define XB_TOP      3328
#define XB_TOPGEN   3392
#define XCD_BAR_WORDS 3456
#define XB_SPIN_CAP (1u << 22)
__device__ __forceinline__ unsigned xb_ld(unsigned* p)              { return __hip_atomic_load(p, __ATOMIC_RELAXED, __HIP_MEMORY_SCOPE_AGENT); }
__device__ __forceinline__ unsigned xb_add(unsigned* p, unsigned v) { return __hip_atomic_fetch_add(p, v, __ATOMIC_RELAXED, __HIP_MEMORY_SCOPE_AGENT); }
__device__ __forceinline__ unsigned xb_xcc_id() { return (unsigned)__builtin_amdgcn_s_getreg((3 << 11) | 20) & 0xFu; }
#define XB_SPIN(cond, bar) do { unsigned _sp = 0; while (cond) { __builtin_amdgcn_s_sleep(1); \
    if ((++_sp & 255u) == 0u) { if (xb_ld(&(bar)[XB_TMO])) break; if (_sp > XB_SPIN_CAP) { atomicAdd(&(bar)[XB_TMO], 1u); break; } } } } while (0)
struct XcdBarrier { unsigned* bar; unsigned x; volatile LAS unsigned* st; };
__device__ __forceinline__ XcdBarrier xcd_barrier_post(unsigned* bar, volatile LAS unsigned* st) {
    XcdBarrier b; b.bar = bar; b.x = xb_xcc_id(); b.st = st;
    if (threadIdx.x == 0) (void)xb_add(&bar[XB_XCNT(b.x)], 1u);
    return b;
}
__device__ __forceinline__ void xcd_barrier_complete(unsigned* bar, unsigned x, unsigned& nloc, unsigned& nx) {
    const unsigned G = gridDim.x * gridDim.y * gridDim.z;
    unsigned sum, cnt, mine, sp = 0u;
    for (;;) {
        sum = 0u; cnt = 0u; mine = 0u;
#pragma unroll
        for (unsigned j = 0; j < 16; ++j) { const unsigned c = xb_ld(&bar[XB_XCNT(j)]); sum += c; cnt += (c > 0u) ? 1u : 0u; mine = (j == x) ? c : mine; }
        if (sum == G) break;
        __builtin_amdgcn_s_sleep(1);
        if ((++sp & 255u) == 0u) { if (xb_ld(&bar[XB_TMO])) break; if (sp > XB_SPIN_CAP) { atomicAdd(&bar[XB_TMO], 1u); break; } }
    }
    nloc = mine > 0u ? mine : 1u; nx = cnt > 0u ? cnt : 1u;
}
__device__ __forceinline__ void xcd_barrier(const XcdBarrier& b) {
    asm volatile("s_waitcnt vmcnt(0)" ::: "memory");
    __syncthreads();
    if (threadIdx.x == 0) {
        unsigned* bar = b.bar;
        __builtin_amdgcn_s_waitcnt(0);
        unsigned nloc = b.st[0], nx = b.st[1];
        if (nloc == 0u) { xcd_barrier_complete(bar, b.x, nloc, nx); b.st[0] = nloc; b.st[1] = nx; }
        const unsigned old = xb_add(&bar[XB_XSUB(b.x)], 1u);
        const unsigned gen = old / nloc;
        if (old + 1u == (gen + 1u) * nloc) {
            __builtin_amdgcn_fence(__ATOMIC_RELEASE, "agent");
            asm volatile("s_waitcnt vmcnt(0)" ::: "memory");
            const unsigned og = xb_add(&bar[XB_TOP], 1u);
            const unsigned tg = og / nx;
            if (og + 1u == (tg + 1u) * nx) xb_add(&bar[XB_TOPGEN], 1u);
            else XB_SPIN(xb_ld(&bar[XB_TOPGEN]) == tg, bar);
            __builtin_amdgcn_fence(__ATOMIC_ACQUIRE, "agent");
            xb_add(&bar[XB_XGEN(b.x)], 1u);
            asm volatile("s_waitcnt vmcnt(0)" ::: "memory");
        } else {
            XB_SPIN(xb_ld(&bar[XB_XGEN(b.x)]) == gen, bar);
            __builtin_amdgcn_fence(__ATOMIC_ACQUIRE, "agent");
            asm volatile("s_waitcnt vmcnt(0)" ::: "memory");
        }
    }
    __syncthreads();
}

namespace pg8 {
#define PG8_LAS __attribute__((address_space(3)))
typedef unsigned short bf16_t;
typedef short bf16x8 __attribute__((ext_vector_type(8)));
typedef float f32x4 __attribute__((ext_vector_type(4)));
typedef unsigned u32x4 __attribute__((ext_vector_type(4)));
constexpr int BM = 256, BK = 64, HALF = 128, HTB = HALF * BK * 2  , STAGE_BYTES = 8 * HTB, NXCD = 8, WGM = 8;

__host__ __device__ __forceinline__ int lds_byte(int r, int c) { const int st = (r >> 4) * 2 + (c >> 5), rr = r & 15, cc = c & 31, ob = rr * 64 + cc * 2; return st * 1024 + (ob ^ (((ob >> 9) & 1) << 5)); }
__host__ __device__ __forceinline__ void stage_rc(int b, int& R, int& C) { const int st = b / 1024, sb = b % 1024, swz = sb ^ (((sb >> 9) & 1) << 5); R = (st >> 1) * 16 + swz / 64; C = (st & 1) * 32 + (swz % 64) / 2; }
__host__ __device__ __forceinline__ int perm32(int rho) { const int n = rho >> 4, i = rho & 15; return 8 * (i >> 2) + 4 * n + (i & 3); }

struct Unit { int pm, pn; };
struct Gemm { const bf16_t* A; const bf16_t* Bt; int M, N, K; };

struct StaticOrder {
    int nM, nN, nwg, G, c;
    __host__ __device__ void init(int M, int N, int G_, int c_) { nM = M / BM; nN = N / BM; nwg = nM * nN; G = G_; c = c_; }
    __host__ __device__ bool next(int i, Unit& u) const {
        const long L = (long)i * G + c; if (L >= nwg) return false;
        int wgid = (int)L; { const int q = nwg / NXCD, r = nwg % NXCD, xcd = wgid % NXCD, off = wgid / NXCD; wgid = (xcd < r ? xcd * (q + 1) : r * (q + 1) + (xcd - r) * q) + off; }
        const int nig = WGM * nN, gid = wgid / nig, fm = gid * WGM, gsz = (nM - fm) < WGM ? (nM - fm) : WGM;
        u.pm = fm + ((wgid % nig) % gsz); u.pn = (wgid % nig) / gsz; return true;
    }
    __device__ __forceinline__ void a_ready(const Unit&) const {}
    __device__ __forceinline__ void done(const Unit&) const {}
};
__device__ __forceinline__ unsigned cvt_pk_bf16(float lo, float hi) { unsigned r; asm volatile("v_cvt_pk_bf16_f32 %0, %1, %2" : "=v"(r) : "v"(lo), "v"(hi)); return r; }
template <class Epi, class Sched, bool ALIGN_EPI = false, bool SP2 = false>
__device__ __forceinline__ void gemm_phase(PG8_LAS unsigned char* lds, const Gemm g, const Sched& S, const Epi& E) {
    int tid = threadIdx.x; asm volatile("" : "+v"(tid));
    const int wid = __builtin_amdgcn_readfirstlane(tid >> 6), lane = tid & 63, wr = wid >> 2, wc = wid & 3, fr = lane & 15, fq = lane >> 4;
    const int K = g.K, nt = K / BK;
    unsigned voffA[2], voffB[2];
#pragma unroll
    for (int i = 0; i < 2; ++i) { int R, C; stage_rc(tid * 16 + i * 8192, R, C); const int Rb = Epi::PERM ? ((R & ~31) + perm32(R & 31)) : R;
        voffA[i] = (unsigned)(R * K + C) * 2u; voffB[i] = (unsigned)(Rb * K + C) * 2u; }
    const size_t kstep = (size_t)(BK * 2);
    const size_t hstep = (size_t)HALF * K * 2;
    const size_t tstep = 2 * hstep;
    const unsigned ldsw = (unsigned)wid * 1024u;
    const int aoff = lds_byte(wr * 64 + fr, fq * 8), boff = lds_byte(wc * 32 + fr, fq * 8);
#define PG8_SA(b, h) (((b) * 2 + (h)) * HTB)
#define PG8_SB(b, h) ((4 + (b) * 2 + (h)) * HTB)
#define PG8_STAGE(bufoff, gbase, voff) do { _Pragma("unroll") for (int _i = 0; _i < 2; ++_i) \
        __builtin_amdgcn_global_load_lds((const unsigned*)((const char*)(gbase) + (voff)[_i]), (PG8_LAS unsigned*)(lds + (bufoff) + ldsw + _i * 8192), 16, 0, 0); } while (0)
#define PG8_LDA(dst, b, h) do { _Pragma("unroll") for (int m = 0; m < 4; ++m) _Pragma("unroll") for (int k = 0; k < 2; ++k) dst[m][k] = *(const PG8_LAS bf16x8*)(lds + PG8_SA(b, h) + aoff + m * 2048 + k * 1024); } while (0)
#define PG8_LDB(dst, b, h) do { _Pragma("unroll") for (int n = 0; n < 2; ++n) _Pragma("unroll") for (int k = 0; k < 2; ++k) dst[n][k] = *(const PG8_LAS bf16x8*)(lds + PG8_SB(b, h) + boff + n * 2048 + k * 1024); } while (0)
#define PG8_MMA(ai, bj, At, Bt) do { __builtin_amdgcn_s_setprio(1); _Pragma("unroll") for (int m = 0; m < 4; ++m) _Pragma("unroll") for (int n = 0; n < 2; ++n) _Pragma("unroll") for (int k = 0; k < 2; ++k) \
        acc[ai][bj][m][n] = __builtin_amdgcn_mfma_f32_16x16x32_bf16(Bt[n][k], At[m][k], acc[ai][bj][m][n], 0, 0, 0); __builtin_amdgcn_s_setprio(0); } while (0)
#define PG8_WAIT_V(n) asm volatile("s_waitcnt vmcnt(" #n ")" ::: "memory")
#define PG8_WAIT_L(n) asm volatile("s_waitcnt lgkmcnt(" #n ")" ::: "memory")
#define PG8_BAR __builtin_amdgcn_s_barrier()
#define PG8_SCHED __builtin_amdgcn_sched_barrier(0)
    Unit cur, nxt; int ui = 0;
    if (!S.next(0, cur)) return;
    f32x4 acc[2][2][4][2];
#pragma unroll
    for (int a = 0; a < 2; ++a)
#pragma unroll
        for (int b = 0; b < 2; ++b)
#pragma unroll
            for (int m = 0; m < 4; ++m)
#pragma unroll
                for (int n = 0; n < 2; ++n) acc[a][b][m][n] = (f32x4){0.f, 0.f, 0.f, 0.f};
    bf16x8 At[4][2], B0[2][2], B1[2][2];
    const char* cA = (const char*)g.A + (size_t)cur.pm * tstep; const char* cB = (const char*)g.Bt + (size_t)cur.pn * tstep;
    S.a_ready(cur);
    if constexpr (SP2) {
        PG8_STAGE(PG8_SB(0, 0), cB, voffB); PG8_STAGE(PG8_SB(0, 1), cB + hstep, voffB); PG8_STAGE(PG8_SA(0, 0), cA, voffA); PG8_STAGE(PG8_SA(0, 1), cA + hstep, voffA);
        if (wr == 1) PG8_BAR;
        PG8_WAIT_V(2); PG8_BAR;
        PG8_STAGE(PG8_SB(1, 0), cB + kstep, voffB); PG8_STAGE(PG8_SA(1, 0), cA + kstep, voffA); PG8_STAGE(PG8_SB(1, 1), cB + hstep + kstep, voffB);
        PG8_WAIT_V(6); PG8_BAR;
    } else {
        PG8_STAGE(PG8_SB(0, 0), cB, voffB); PG8_STAGE(PG8_SA(0, 0), cA, voffA); PG8_STAGE(PG8_SB(0, 1), cB + hstep, voffB); PG8_STAGE(PG8_SA(0, 1), cA + hstep, voffA);
        if (wr == 1) PG8_BAR;
        PG8_WAIT_V(4); PG8_BAR;
        PG8_STAGE(PG8_SB(1, 0), cB + kstep, voffB); PG8_STAGE(PG8_SA(1, 0), cA + kstep, voffA); PG8_STAGE(PG8_SB(1, 1), cB + hstep + kstep, voffB);
        PG8_WAIT_V(6); PG8_BAR;
    }
    for (;;) {
        const bool has_next = S.next(ui + 1, nxt);
        const char* nA = has_next ? (const char*)g.A + (size_t)nxt.pm * tstep : cA; const char* nB = has_next ? (const char*)g.Bt + (size_t)nxt.pn * tstep : cB;
        for (int t = 0; t < nt; t += 2) {
            const bool last = (t == nt - 2);
            const char* a1 = cA + (size_t)(t + 1) * kstep;
            const char* a2 = last ? nA : cA + (size_t)(t + 2) * kstep; const char* b2 = last ? nB : cB + (size_t)(t + 2) * kstep;
            const char* a3 = a2 + kstep; const char* b3 = b2 + kstep;
            if (last && has_next) S.a_ready(nxt);
            if constexpr (SP2) {
            PG8_LDB(B0, 0, 0); PG8_LDB(B1, 0, 1); PG8_SCHED; PG8_LDA(At, 0, 0); PG8_STAGE(PG8_SA(1, 1), a1 + hstep, voffA);
            PG8_WAIT_V(8); PG8_WAIT_L(0); PG8_BAR; PG8_MMA(0, 0, At, B0); PG8_MMA(0, 1, At, B1); PG8_BAR; PG8_SCHED;
            PG8_LDA(At, 0, 1); PG8_STAGE(PG8_SB(0, 0), b2, voffB); PG8_STAGE(PG8_SB(0, 1), b2 + hstep, voffB); PG8_STAGE(PG8_SA(0, 0), a2, voffA);
            PG8_WAIT_V(8); PG8_WAIT_L(0); PG8_BAR; PG8_MMA(1, 0, At, B0); PG8_MMA(1, 1, At, B1); PG8_BAR; PG8_SCHED;
            PG8_LDB(B0, 1, 0); PG8_LDB(B1, 1, 1); PG8_SCHED; PG8_LDA(At, 1, 0); PG8_STAGE(PG8_SA(0, 1), a2 + hstep, voffA);
            PG8_WAIT_V(8); PG8_WAIT_L(0); PG8_BAR; PG8_MMA(0, 0, At, B0); PG8_MMA(0, 1, At, B1); PG8_BAR; PG8_SCHED;
            PG8_LDA(At, 1, 1); PG8_STAGE(PG8_SB(1, 0), b3, voffB); PG8_STAGE(PG8_SB(1, 1), b3 + hstep, voffB); PG8_STAGE(PG8_SA(1, 0), a3, voffA);
            PG8_WAIT_V(8); PG8_WAIT_L(0); PG8_BAR; PG8_MMA(1, 0, At, B0); PG8_MMA(1, 1, At, B1); PG8_BAR; PG8_SCHED;
            } else {
            PG8_LDB(B0, 0, 0); PG8_SCHED; PG8_LDA(At, 0, 0); PG8_STAGE(PG8_SA(1, 1), a1 + hstep, voffA);
            PG8_WAIT_L(8); PG8_BAR; PG8_WAIT_L(0); PG8_MMA(0, 0, At, B0); PG8_BAR; PG8_SCHED;
            PG8_LDB(B1, 0, 1); PG8_STAGE(PG8_SB(0, 0), b2, voffB);
            PG8_BAR; PG8_WAIT_L(0); PG8_MMA(0, 1, At, B1); PG8_BAR;
            PG8_LDA(At, 0, 1); PG8_STAGE(PG8_SA(0, 0), a2, voffA);
            PG8_BAR; PG8_WAIT_L(0); PG8_MMA(1, 0, At, B0); PG8_BAR; PG8_SCHED;
            PG8_STAGE(PG8_SB(0, 1), b2 + hstep, voffB);
            PG8_WAIT_V(6); PG8_BAR; PG8_MMA(1, 1, At, B1); PG8_BAR;
            PG8_LDB(B0, 1, 0); PG8_SCHED; PG8_LDA(At, 1, 0); PG8_STAGE(PG8_SA(0, 1), a2 + hstep, voffA);
            PG8_WAIT_L(8); PG8_BAR; PG8_WAIT_L(0); PG8_MMA(0, 0, At, B0); PG8_BAR; PG8_SCHED;
            PG8_LDB(B1, 1, 1); PG8_STAGE(PG8_SB(1, 0), b3, voffB);
            PG8_BAR; PG8_WAIT_L(0); PG8_MMA(0, 1, At, B1); PG8_BAR;
            PG8_LDA(At, 1, 1); PG8_STAGE(PG8_SA(1, 0), a3, voffA);
            PG8_BAR; PG8_WAIT_L(0); PG8_MMA(1, 0, At, B0); PG8_BAR; PG8_SCHED;
            PG8_STAGE(PG8_SB(1, 1), b3 + hstep, voffB);
            PG8_WAIT_V(6); PG8_BAR; PG8_MMA(1, 1, At, B1); PG8_BAR;
            }
        }
        if constexpr (ALIGN_EPI) { if (wr == 0) PG8_BAR; }
        if constexpr (!Epi::AFTER_DRAIN) { E(acc, cur, wr, wc, fr, fq); S.done(cur); }
        if (!has_next) break;
#pragma unroll
        for (int a = 0; a < 2; ++a)
#pragma unroll
            for (int b = 0; b < 2; ++b)
#pragma unroll
                for (int m = 0; m < 4; ++m)
#pragma unroll
                    for (int n = 0; n < 2; ++n) acc[a][b][m][n] = (f32x4){0.f, 0.f, 0.f, 0.f};
        cur = nxt; cA = nA; cB = nB; ++ui;
        if constexpr (ALIGN_EPI) { if (wr == 1) PG8_BAR; }
    }
    PG8_WAIT_V(0);
    if constexpr (!ALIGN_EPI) { if (wr == 0) PG8_BAR; }
    PG8_BAR;
    if constexpr (Epi::AFTER_DRAIN) { E.fused(acc, cur, wr, wc, fr, fq, lds, wid, lane); S.done(cur); }
#undef PG8_SA
#undef PG8_SB
#undef PG8_STAGE
#undef PG8_LDA
#undef PG8_LDB
#undef PG8_MMA
#undef PG8_WAIT_V
#undef PG8_WAIT_L
#undef PG8_BAR
#undef PG8_SCHED
}
}

typedef short bf16x8 __attribute__((ext_vector_type(8)));
typedef float f32x4 __attribute__((ext_vector_type(4)));
typedef unsigned u32x4 __attribute__((ext_vector_type(4)));
typedef unsigned u32x2 __attribute__((ext_vector_type(2)));
constexpr int NTHREADS = 512, NWAVES = 8, LDS_BYTES = 147456;
constexpr int REP_P0 = 1, REP_P1 = 1, REP_P2 = 1, REP_P3 = 1, REP_P4 = 1, PROBE_VAR = 0;
#endif
#ifdef HOST_EMU
#define DEV static inline
#define LDSQ
#define TIDX emu_tid()
#define BIDX emu_bid()
#define GDIM emu_gdim()
#define SYNCTHREADS() emu_syncthreads()
#define WAVE_SYNC() emu_wave_sync()
#define MFMA16(a, b, c) emu_mfma16(a, b, c)
#define SHFL_XOR(v, m) emu_shfl_xor(v, m)
#define BALLOT(p) emu_ballot(p)
#define EXP2F(x) exp2f(x)
#define LOG2F(x) log2f(x)
#define LDS_ATOMIC_ADD(ptr, v) (*(ptr) += (v))
#define FETCH_ADD_U32(ptr, v) __atomic_fetch_add(ptr, v, __ATOMIC_RELAXED)
#define XCC_ID() (emu_bid() % 8)
static inline unsigned f_as_u(float f) { union { unsigned u; float f; } c; c.f = f; return c.u; }
static inline unsigned cvtpk(float lo, float hi) { return (unsigned)f2bf(lo) | ((unsigned)f2bf(hi) << 16); }
#else
#define DEV __device__ __forceinline__
#define LDSQ LAS
__device__ __forceinline__ int opaque_tid() { int t = (int)threadIdx.x; asm volatile("" : "+v"(t)); return t; }
#define TIDX opaque_tid()
#define BIDX ((int)blockIdx.x)
#define GDIM ((int)gridDim.x)
#define SYNCTHREADS() __syncthreads()
#define WAVE_SYNC() asm volatile("s_waitcnt lgkmcnt(0)" ::: "memory")
#define MFMA16(a, b, c) __builtin_amdgcn_mfma_f32_16x16x32_bf16(a, b, c, 0, 0, 0)
#define SHFL_XOR(v, m) __shfl_xor(v, m)
#define BALLOT(p) __ballot(p)
#define EXP2F(x) __builtin_amdgcn_exp2f(x)
#define LOG2F(x) __builtin_amdgcn_logf(x)
#define LDS_ATOMIC_ADD(ptr, v) atomicAdd((float*)(ptr), v)
#define FETCH_ADD_U32(ptr, v) __hip_atomic_fetch_add(ptr, v, __ATOMIC_RELAXED, __HIP_MEMORY_SCOPE_AGENT)
#define XCC_ID() ((int)xb_xcc_id())
__device__ __forceinline__ unsigned f_as_u(float f) { return __float_as_uint(f); }
__device__ __forceinline__ unsigned cvtpk(float lo, float hi) { unsigned r; asm("v_cvt_pk_bf16_f32 %0, %1, %2" : "=v"(r) : "v"(lo), "v"(hi)); return r; }
#endif

constexpr float LOG2E = 1.4426950408889634f, NEGF = -1e30f;
constexpr int NTH = 512, NWV = 8;
constexpr int A_STAGE = 0, A_STAGE_BYTES = 16384;
constexpr int A_IMP = 49152;
constexpr int A_BIAS = 81920;
constexpr int A_SELM = A_BIAS + 4352;
constexpr int A_MISC = A_SELM + 1024;
constexpr int A_END = A_MISC + 64;
HD int perm32k(int kk) { return (kk & 3) + 4 * ((kk >> 4) & 1) + 8 * ((kk >> 2) & 3); }

constexpr int HS_STRIDE = 272;
DEV void p2_compress_unit(const Params& p, LDSQ unsigned char* lds, int u) {
    const int tid = TIDX, lane = tid & 63, wave = tid >> 6, fr = lane & 15, fq = lane >> 4;
    constexpr int NCT = NCP / 32;
    const int ct = u % NCT, bg = (u / NCT) % (NB * NG), w = u / (NCT * NB * NG), c0 = 32 * ct;
    const bf16* src = p.kv[0] + (size_t)w * KVSZ + (size_t)bg * S * 64;
    const bf16* w1 = p.w1t[0] + (size_t)w * (128 * 2048);
    f32x4 acc[2] = {{0.f, 0.f, 0.f, 0.f}, {0.f, 0.f, 0.f, 0.f}};
    const bf16* a0 = src + (size_t)(c0 + fr) * 1024 + 8 * fq, *a1 = a0 + 16 * 1024, *bp = w1 + (size_t)(16 * wave + fr) * 2048 + 8 * fq;
#pragma unroll 8
    for (int ks = 0; ks < 64; ++ks) {
        const bf16x8 fa0 = *(const bf16x8*)(a0 + 32 * ks), fa1 = *(const bf16x8*)(a1 + 32 * ks), fb = *(const bf16x8*)(bp + 32 * ks);
        acc[0] = MFMA16(fa0, fb, acc[0]); acc[1] = MFMA16(fa1, fb, acc[1]);
    }
    const float pb = p.peb[0][w * 128 + 16 * wave + fr];
#pragma unroll
    for (int mt = 0; mt < 2; ++mt)
#pragma unroll
        for (int r = 0; r < 4; ++r) *(LDSQ bf16*)(lds + (16 * mt + 4 * fq + r) * HS_STRIDE + (16 * wave + fr) * 2) = f2bf(siluf(acc[mt][r] + pb));
    SYNCTHREADS();
    {
        const int mt = wave & 1, dt = wave >> 1; const bf16* w2 = p.w2t[0] + (size_t)w * (64 * 128) + (size_t)(16 * dt + fr) * 128 + 8 * fq;
        f32x4 o = {0.f, 0.f, 0.f, 0.f};
#pragma unroll
        for (int ks = 0; ks < 4; ++ks) { const bf16x8 fa = *(LDSQ const bf16x8*)(lds + (16 * mt + fr) * HS_STRIDE + (32 * ks + 8 * fq) * 2), fb = *(const bf16x8*)(w2 + 32 * ks); o = MFMA16(fa, fb, o); }
        const int d = 16 * dt + fr, cb = c0 + 16 * mt + 4 * fq;
        if (w == 0) {
#pragma unroll
            for (int r = 0; r < 4; ++r) p.kcvc[0][((size_t)bg * NCP + cb + r) * 64 + d] = (cb + r == NCP - 1) ? (bf16)0 : f2bf(o[r]);
        } else {
            u32x2 pk; pk[0] = cvtpk(o[0], o[1]); pk[1] = cvtpk(o[2], (cb + 3 == NCP - 1) ? 0.f : o[3]);
            *(u32x2*)(p.vct + (((size_t)bg * (NCP / 64) + (cb >> 6)) * 64 + d) * 64 + (cb & 32) + perm32k(cb & 31)) = pk;
        }
    }
    SYNCTHREADS();
}
constexpr int TS = 72;
DEV void p2_transpose_item(const Params& p, LDSQ unsigned char* lds, int it) {
    const int tid = TIDX, lane = tid & 63, wave = tid >> 6;
    const int nb = it % NSEL, bg = (it / NSEL) % (NB * NG), ten = it / (NSEL * NB * NG);
    const bf16* src = p.kv[0] + (size_t)(ten ? 5 : 3) * KVSZ + ((size_t)bg * S + 64 * nb) * 64;
    bf16* dst = (ten ? p.vtw : p.vts) + ((size_t)bg * NSEL + nb) * 4096;
    LDSQ bf16* tb = (LDSQ bf16*)(lds + wave * (64 * TS * 2));
#pragma unroll
    for (int i = 0; i < 8; ++i) { const int row = 8 * i + (lane >> 3), ch = lane & 7; const bf16x8 v = *(const bf16x8*)(src + row * 64 + ch * 8);
        const int pr = (row & 32) + perm32k(row & 31);
#pragma unroll
        for (int j = 0; j < 8; ++j) tb[(ch * 8 + j) * TS + pr] = (bf16)v[j]; }
    WAVE_SYNC();
#pragma unroll
    for (int i = 0; i < 8; ++i) { const int d = 8 * i + (lane >> 3), ch = lane & 7; *(bf16x8*)(dst + d * 64 + ch * 8) = *(LDSQ const bf16x8*)(tb + d * TS + ch * 8); }
    WAVE_SYNC();
}
DEV void p2_conv_item(const Params& p, long it) {
    const long row = it >> 6; const int c8 = (int)(it & 63) * 8, t = (int)(row % S);
    const bf16* hb = p.reg5[0] + R5SZ, *bb = hb + R5SZ, *cb = bb + R5SZ, *zb = cb + R5SZ;
    float y[8];
#pragma unroll
    for (int j = 0; j < 8; ++j) y[j] = 0.f;
#pragma unroll
    for (int k = 0; k < 3; ++k) { if (t - 2 + k < 0) continue; const size_t o = (size_t)(row - 2 + k) * 512 + c8;
        const bf16x8 h8 = *(const bf16x8*)(hb + o), cc8 = *(const bf16x8*)(cb + o); const f32x4 w0 = *(const f32x4*)(p.conv_w + k * 512 + c8), w1 = *(const f32x4*)(p.conv_w + k * 512 + c8 + 4);
#pragma unroll
        for (int j = 0; j < 8; ++j) y[j] += (j < 4 ? w0[j & 3] : w1[j & 3]) * (bf2f((bf16)cc8[j]) * bf2f((bf16)h8[j])); }
    const bf16x8 b8 = *(const bf16x8*)(bb + (size_t)row * 512 + c8), z8 = *(const bf16x8*)(zb + (size_t)row * 512 + c8);
    u32x4 o;
#pragma unroll
    for (int j = 0; j < 4; ++j) o[j] = cvtpk(bf2f((bf16)b8[2 * j]) * y[2 * j] * siluf(bf2f((bf16)z8[2 * j])), bf2f((bf16)b8[2 * j + 1]) * y[2 * j + 1] * siluf(bf2f((bf16)z8[2 * j + 1])));
    *(u32x4*)(p.mixed + (size_t)row * 1024 + 512 + c8) = o;
}
DEV void p2_phase(const Params& p, LDSQ unsigned char* lds) {
    const int tid = TIDX, wave = tid >> 6;
    constexpr int NCU = 2 * NB * NG * (NCP / 32);
    for (int u = BIDX; u < NCU; u += GDIM) p2_compress_unit(p, lds, u);
    const int gw = BIDX * NWV + wave, NGW = GDIM * NWV;
    for (int it = NGW - 1 - gw; it < 2 * NB * NG * NSEL; it += NGW) p2_transpose_item(p, lds, it);
    const long T = (long)GDIM * NTH;
    for (long it = (long)(GDIM - 1 - BIDX) * NTH + tid; it < (long)ROWS * 64; it += T) p2_conv_item(p, it);
}

#ifdef HOST_EMU
static inline float xmax16(float v) { return fmaxf(v, emu_shfl_xor(v, 16)); }
static inline float xmax32(float v) { return fmaxf(v, emu_shfl_xor(v, 32)); }
static inline float xsum16(float v) { return v + emu_shfl_xor(v, 16); }
static inline float xsum32(float v) { return v + emu_shfl_xor(v, 32); }
static inline float quad_sum(float v) { v += emu_shfl_xor(v, 1); v += emu_shfl_xor(v, 2); return v; }
#define SCHED_BARRIER()
#define WAVE_UNIFORM(x) (x)
#define OPAQUE_I(x)
#define OPAQUE_F(x)
#define PIN_V4(x)
#define GLDS16(gsrc, ldsdst, lane) memcpy((ldsdst) + 16 * (lane), (gsrc), 16)
#define VM_WAIT2()
#define VM_WAIT0()
#define BLOCK_BARRIER() emu_syncthreads()
#else
__device__ __forceinline__ float xmax16(float v) { const auto r = __builtin_amdgcn_permlane16_swap(__float_as_uint(v), __float_as_uint(v), false, false); return fmaxf(__uint_as_float(r[0]), __uint_as_float(r[1])); }
__device__ __forceinline__ float xmax32(float v) { const auto r = __builtin_amdgcn_permlane32_swap(__float_as_uint(v), __float_as_uint(v), false, false); return fmaxf(__uint_as_float(r[0]), __uint_as_float(r[1])); }
__device__ __forceinline__ float xsum16(float v) { const auto r = __builtin_amdgcn_permlane16_swap(__float_as_uint(v), __float_as_uint(v), false, false); return __uint_as_float(r[0]) + __uint_as_float(r[1]); }
__device__ __forceinline__ float xsum32(float v) { const auto r = __builtin_amdgcn_permlane32_swap(__float_as_uint(v), __float_as_uint(v), false, false); return __uint_as_float(r[0]) + __uint_as_float(r[1]); }
__device__ __forceinline__ float quad_sum(float v) {
    v += __int_as_float(__builtin_amdgcn_update_dpp(0, __float_as_int(v), 0xB1, 0xf, 0xf, true));
    v += __int_as_float(__builtin_amdgcn_update_dpp(0, __float_as_int(v), 0x4E, 0xf, 0xf, true));
    return v; }
#define SCHED_BARRIER() __builtin_amdgcn_sched_barrier(0)
#define WAVE_UNIFORM(x) __builtin_amdgcn_readfirstlane(x)
#define OPAQUE_I(x) asm volatile("" : "+v"(x))
#define OPAQUE_F(x) asm volatile("" : "+v"(x))
#define PIN_V4(x) asm volatile("" : "+v"(x))
__device__ __forceinline__ void glds16_asm(const void* gsrc, unsigned lds_dst) { unsigned keep;
    asm volatile("s_mov_b32 %0, m0\n\ts_mov_b32 m0, %2\n\ts_nop 0\n\tglobal_load_lds_dwordx4 %1, off\n\ts_mov_b32 m0, %0" : "=&s"(keep) : "v"(gsrc), "s"(lds_dst) : "memory"); }
#define GLDS16(gsrc, ldsdst, lane) glds16_asm((const void*)(gsrc), (unsigned)__builtin_amdgcn_readfirstlane((int)(unsigned)(unsigned long)(ldsdst)))
#define VM_WAIT2() asm volatile("s_waitcnt vmcnt(2)" ::: "memory")
#define VM_WAIT0() asm volatile("s_waitcnt vmcnt(0)" ::: "memory")
#define BLOCK_BARRIER() do { asm volatile("s_waitcnt lgkmcnt(0)" ::: "memory"); __builtin_amdgcn_s_barrier(); asm volatile("" ::: "memory"); } while (0)
#endif
DEV void ld_frags(bf16x8 (&f)[8], LDSQ const unsigned char* img, int fr, int fq) {
    LDSQ const unsigned char* b0 = img + fr * 128 + ((fq ^ (fr & 7)) << 4); LDSQ const unsigned char* b1 = img + fr * 128 + (((4 + fq) ^ (fr & 7)) << 4);
#pragma unroll
    for (int t = 0; t < 4; ++t) { f[2 * t] = *(LDSQ const bf16x8*)(b0 + t * 2048); f[2 * t + 1] = *(LDSQ const bf16x8*)(b1 + t * 2048); }
}
DEV void qk2(const bf16x8 (&kf)[8], const bf16x8 (&qf)[2], f32x4 (&s)[4], float init) {
#pragma unroll
    for (int kt = 0; kt < 4; ++kt) { f32x4 a = {init, init, init, init}; a = MFMA16(kf[2 * kt], qf[0], a); a = MFMA16(kf[2 * kt + 1], qf[1], a); s[kt] = a; }
}
DEV void pv2(const bf16x8 (&vf)[8], const bf16x8 (&pb)[2], f32x4 (&o)[4]) {
#pragma unroll
    for (int dt = 0; dt < 4; ++dt) { o[dt] = MFMA16(vf[2 * dt], pb[0], o[dt]); o[dt] = MFMA16(vf[2 * dt + 1], pb[1], o[dt]); }
}
DEV void pack_p(const f32x4 (&pv)[4], bf16x8 (&pb)[2]) {
#pragma unroll
    for (int i = 0; i < 2; ++i) { u32x4 w; w[0] = cvtpk(pv[2 * i][0], pv[2 * i][1]); w[1] = cvtpk(pv[2 * i][2], pv[2 * i][3]); w[2] = cvtpk(pv[2 * i + 1][0], pv[2 * i + 1][1]); w[3] = cvtpk(pv[2 * i + 1][2], pv[2 * i + 1][3]); pb[i] = (bf16x8)w; }
}
DEV void bias_mask(f32x4 (&s)[4], LDSQ const float* btab, int tqe, int kstride, int dmax, int h, int fq) {
    OPAQUE_I(tqe); OPAQUE_I(fq);
    const int base = tqe - kstride * 4 * fq; LDSQ const float* bt = btab + h;
    float bv[16];
#pragma unroll
    for (int i = 0; i < 16; ++i) { const int dist = base - kstride * (16 * (i >> 2) + (i & 3)); int bi = dist < 0 ? 0 : dist; bi = bi > 128 ? 128 : bi; bv[i] = bt[bi * 8]; }
#pragma unroll
    for (int i = 0; i < 16; ++i) OPAQUE_F(bv[i]);
#pragma unroll
    for (int i = 0; i < 16; ++i) { const int dist = base - kstride * (16 * (i >> 2) + (i & 3)); s[i >> 2][i & 3] = ((unsigned)dist <= (unsigned)dmax) ? s[i >> 2][i & 3] + bv[i] : NEGF; }
}
DEV float tile_max(const f32x4 (&s)[4]) {
    float m = fmaxf(fmaxf(s[0][0], s[0][1]), fmaxf(s[0][2], s[0][3]));
#pragma unroll
    for (int kt = 1; kt < 4; ++kt) m = fmaxf(m, fmaxf(fmaxf(s[kt][0], s[kt][1]), fmaxf(s[kt][2], s[kt][3])));
    return xmax32(xmax16(m));
}
DEV void mask_only(f32x4 (&s)[4], int tqe, int dmax, int fq) {
    OPAQUE_I(tqe); OPAQUE_I(fq);
    const int base = tqe - 4 * fq;
#pragma unroll
    for (int i = 0; i < 16; ++i) { const int dist = base - (16 * (i >> 2) + (i & 3)); s[i >> 2][i & 3] = ((unsigned)dist <= (unsigned)dmax) ? s[i >> 2][i & 3] : NEGF; }
}
constexpr float LAZY_THR = 8.f;
DEV void softmax_lazy(f32x4 (&s)[4], float& mref, float base, f32x4& lacc, f32x4 (&o)[4], bool colsel, bf16x8 (&pb)[2]) {
    const float tmax = tile_max(s); const bool fresh = mref <= -5e29f;
    const bool need = colsel && tmax > -5e29f && (fresh || tmax > LAZY_THR);
    if (BALLOT(need) != 0ull) {
        const float d = need ? tmax : 0.f, alpha = (need && !fresh) ? EXP2F(-d) : 1.f;
#pragma unroll
        for (int kt = 0; kt < 4; ++kt) s[kt] = s[kt] - d;
        mref = need ? base + d : mref;
#pragma unroll
        for (int dt = 0; dt < 4; ++dt) o[dt] = o[dt] * alpha;
        lacc = lacc * alpha;
    }
#pragma unroll
    for (int kt = 0; kt < 4; ++kt)
#pragma unroll
        for (int r = 0; r < 4; ++r) s[kt][r] = EXP2F(s[kt][r]);
    pack_p(s, pb);
}
DEV void stats_lazy(f32x4 (&s)[4], float& mref, float base, float& lsum) {
    const float tmax = tile_max(s); const bool fresh = mref <= -5e29f;
    const bool need = tmax > -5e29f && (fresh || tmax > LAZY_THR);
    if (BALLOT(need) != 0ull) {
        const float d = need ? tmax : 0.f, alpha = (need && !fresh) ? EXP2F(-d) : 1.f;
#pragma unroll
        for (int kt = 0; kt < 4; ++kt) s[kt] = s[kt] - d;
        mref = need ? base + d : mref; lsum *= alpha;
    }
    float ps = 0.f;
#pragma unroll
    for (int kt = 0; kt < 4; ++kt)
#pragma unroll
        for (int r = 0; r < 4; ++r) ps += EXP2F(s[kt][r]);
    lsum += ps;
}
DEV void pv2l(const bf16x8 (&vf)[8], const bf16x8 (&pb)[2], f32x4 (&o)[4], f32x4& lacc, const bf16x8& ones) {
#pragma unroll
    for (int dt = 0; dt < 4; ++dt) { o[dt] = MFMA16(vf[2 * dt], pb[0], o[dt]); o[dt] = MFMA16(vf[2 * dt + 1], pb[1], o[dt]); }
    lacc = MFMA16(ones, pb[0], lacc); lacc = MFMA16(ones, pb[1], lacc);
}
DEV void sub_all(f32x4 (&s)[4], float v) {
#pragma unroll
    for (int kt = 0; kt < 4; ++kt) s[kt] = s[kt] - v;
}

template <int VAR> DEV void attn_unit(const Params& p, LDSQ unsigned char* lds, int bg, int blk) {
    const int tid = TIDX, lane = tid & 63, wave = WAVE_UNIFORM(tid >> 6), fr = lane & 15, fq = lane >> 4;
    const int b = bg / NG, g = bg % NG, t0 = 64 * blk;
    const int r = fr & 3, h = 4 * g + r;
    LDSQ float* btab = (LDSQ float*)(lds + A_BIAS);
    LDSQ float* imp = (LDSQ float*)(lds + A_IMP);
    LDSQ unsigned long long* selm = (LDSQ unsigned long long*)(lds + A_SELM);
    int tq[2]; bf16x8 qf[2][2];
#pragma unroll
    for (int cg = 0; cg < 2; ++cg) { tq[cg] = t0 + 8 * wave + 4 * cg + (fr >> 2);
        const bf16* qp = p.q + (((size_t)b * NH + h) * S + tq[cg]) * 64 + 8 * fq; qf[cg][0] = *(const bf16x8*)qp; qf[cg][1] = *(const bf16x8*)(qp + 32); }
    PIN_V4(qf[0][0]); PIN_V4(qf[0][1]); PIN_V4(qf[1][0]); PIN_V4(qf[1][1]);
    for (int i = lane; i < 8 * 128; i += 64) imp[(8 * wave) * 128 + i] = 0.f;
    const int ncb = ((4 * blk + 2) >> 6) + 1, nslc = blk + 1, wb0 = blk > 8 ? blk - 8 : 0, nwin = blk - wb0 + 1, j_slc = 2 * ncb, j_win = j_slc + nslc, njobs = j_win + nwin;
    const bf16* kcb = p.kcvc[0] + (size_t)bg * NCP * 64; const bf16* vcb = p.vct + (size_t)bg * NCP * 64;
    const bf16* ksb = p.kv[0] + 2 * KVSZ + (size_t)bg * S * 64; const bf16* vsb = p.vts + (size_t)bg * S * 64;
    const bf16* kwb = p.kv[0] + 4 * KVSZ + (size_t)bg * S * 64; const bf16* vwb = p.vtw + (size_t)bg * S * 64;
    const int soff = ((tid >> 3) * 64 + (((tid & 7) ^ ((tid >> 3) & 7)) << 3));
#define STAGE_DMA(j) do { const int j_ = (j); const bf16* ks_; const bf16* vs_; \
        if (j_ < j_slc) { const int cb_ = j_ < ncb ? j_ : j_ - ncb; ks_ = kcb + (size_t)cb_ * 4096; vs_ = vcb + (size_t)cb_ * 4096; } \
        else if (j_ < j_win) { const int n_ = j_ - j_slc; ks_ = ksb + (size_t)n_ * 4096; vs_ = vsb + (size_t)n_ * 4096; } \
        else { const int n_ = wb0 + j_ - j_win; ks_ = kwb + (size_t)n_ * 4096; vs_ = vwb + (size_t)n_ * 4096; } \
        LDSQ unsigned char* sb_ = lds + A_STAGE + (j_ % 3) * A_STAGE_BYTES + wave * 1024; GLDS16(ks_ + soff, sb_, lane); GLDS16(vs_ + soff, sb_ + 8192, lane); } while (0)
    STAGE_DMA(0);
    if (njobs > 1) STAGE_DMA(1);
    if (njobs > 1) { VM_WAIT2(); } else { VM_WAIT0(); }
    BLOCK_BARRIER();
    float m[2] = {NEGF, NEGF}, l[2] = {0.f, 0.f};
    f32x4 o[2][4], lacc[2];
#pragma unroll
    for (int cg = 0; cg < 2; ++cg) { lacc[cg] = (f32x4){0.f, 0.f, 0.f, 0.f};
#pragma unroll
        for (int dt = 0; dt < 4; ++dt) o[cg][dt] = (f32x4){0.f, 0.f, 0.f, 0.f}; }
    const float bfar = btab[128 * 8 + h];
    bf16x8 ones; { const short ov = fr == 0 ? (short)0x3F80 : (short)0; ones = (bf16x8){ov, ov, ov, ov, ov, ov, ov, ov}; }
    const int cfar = t0 >= 159 ? ((t0 - 159) >> 4) : -1;
    for (int j = 0; j < njobs; ++j) {
        if (j + 2 < njobs) STAGE_DMA(j + 2);
        LDSQ const unsigned char* kimg = lds + A_STAGE + (j % 3) * A_STAGE_BYTES; LDSQ const unsigned char* vimg = kimg + 8192;
        bool drain = false;
        if ((VAR & 2) || ((VAR & 8) && j < j_slc) || ((VAR & 16) && j >= j_win)) {   } else
        if (j < ncb) {
            const bool far = 64 * j + 63 <= cfar;
            bf16x8 kf[8]; ld_frags(kf, kimg, fr, fq);
#pragma unroll
            for (int cg = 0; cg < 2; ++cg) { f32x4 s[4]; const float base = m[cg] <= -5e29f ? 0.f : m[cg];
                if (far) qk2(kf, qf[cg], s, bfar - base);
                else { qk2(kf, qf[cg], s, 0.f); bias_mask(s, btab, tq[cg] - 31 - 16 * 64 * j, 16, 1 << 30, h, fq); sub_all(s, base); }
                stats_lazy(s, m[cg], base, l[cg]); }
            if (j == ncb - 1) {
#pragma unroll
                for (int cg = 0; cg < 2; ++cg) { const float lt = xsum32(xsum16(l[cg])); m[cg] = m[cg] <= -5e29f ? 0.f : m[cg] + LOG2F(fmaxf(lt, 1e-30f)); }
            }
        } else if (j < j_slc) {
            const int cb = j - ncb; const bool far = 64 * cb + 63 <= cfar;
#pragma unroll
            for (int cg = 0; cg < 2; ++cg) { f32x4 s[4]; bf16x8 pb[2];
                { bf16x8 kf[8]; ld_frags(kf, kimg, fr, fq);
                  if (far) qk2(kf, qf[cg], s, bfar - m[cg]);
                  else { qk2(kf, qf[cg], s, 0.f); bias_mask(s, btab, tq[cg] - 31 - 16 * 64 * cb, 16, 1 << 30, h, fq); sub_all(s, m[cg]); } }
#pragma unroll
                for (int kt = 0; kt < 4; ++kt) {
#pragma unroll
                    for (int rr = 0; rr < 4; ++rr) s[kt][rr] = EXP2F(s[kt][rr]);
                    const float s4 = quad_sum((s[kt][0] + s[kt][1]) + (s[kt][2] + s[kt][3])), p3 = quad_sum(s[kt][3]);
                    if (r == 0) { int fq_ = fq; OPAQUE_I(fq_); const int n = 16 * cb + 4 * kt + fq_, ql = 8 * wave + 4 * cg + (fr >> 2); LDS_ATOMIC_ADD(&imp[ql * 128 + n], s4); if (n + 1 < NSEL) LDS_ATOMIC_ADD(&imp[ql * 128 + n + 1], p3); }
                }
                pack_p(s, pb);
                { bf16x8 vf[8]; ld_frags(vf, vimg, fr, fq); pv2(vf, pb, o[cg]); } }
            if (j == j_slc - 1) {
                drain = true;
#pragma unroll
                for (int cg = 0; cg < 2; ++cg) { m[cg] = NEGF; l[cg] = 0.f; int tq_ = tq[cg]; OPAQUE_I(tq_); const float g0_ = p.gates[((size_t)b * S + tq_) * 24 + h]; float* ap = p.attn_acc + ((size_t)b * S + tq_) * 512 + h * 64 + 4 * fq;
#pragma unroll
                    for (int dt = 0; dt < 4; ++dt) { *(f32x4*)(ap + 16 * dt) = o[cg][dt] * g0_; o[cg][dt] = (f32x4){0.f, 0.f, 0.f, 0.f}; } }
                WAVE_SYNC();
                int lane_ = lane; OPAQUE_I(lane_);
                for (int qq = 0; qq < ((VAR & 4) ? 0 : 8); ++qq) { const int ql = 8 * wave + qq;
                    const int n0 = lane_, n1 = lane_ + 64; const float v0 = imp[ql * 128 + n0], v1 = imp[ql * 128 + n1];
                    const unsigned k0 = n0 > blk ? 0u : ((n0 == 0 || n0 == blk || n0 == blk - 1) ? 0xFFFFFFFFu : f_as_u(v0) + 1u);
                    const unsigned k1 = n1 > blk ? 0u : ((n1 == blk || n1 == blk - 1) ? 0xFFFFFFFFu : f_as_u(v1) + 1u);
                    unsigned T = 0u;
                    for (int bit = 31; bit >= 0; --bit) { const unsigned cand = T | (1u << bit); const int cnt = __builtin_popcountll(BALLOT(k0 >= cand)) + __builtin_popcountll(BALLOT(k1 >= cand)); if (cnt >= KTOP) T = cand; }
                    const bool g0b = k0 > T, g1b = k1 > T; const int need = KTOP - (__builtin_popcountll(BALLOT(g0b)) + __builtin_popcountll(BALLOT(g1b)));
                    const unsigned long long be0 = BALLOT(k0 == T), be1 = BALLOT(k1 == T), lt = (1ull << lane_) - 1ull;
                    const int r0 = __builtin_popcountll(be0 & lt), r1 = __builtin_popcountll(be0) + __builtin_popcountll(be1 & lt);
                    const unsigned long long sl0 = BALLOT((g0b || (k0 == T && r0 < need)) && n0 <= blk), sl1 = BALLOT((g1b || (k1 == T && r1 < need)) && n1 <= blk);
                    if (lane_ == 0) { selm[ql * 2] = sl0; selm[ql * 2 + 1] = sl1; } }
                WAVE_SYNC();
            }
        } else {
            const bool slc = j < j_win; const int n = slc ? j - j_slc : wb0 + j - j_win;
            const bool near = n + 2 >= blk, edge = !slc && n + 8 == blk;
            bool cs0 = true, cs1 = true;
            if (slc) { int fr_ = fr; OPAQUE_I(fr_); const int qb = 8 * wave + (fr_ >> 2); cs0 = ((selm[qb * 2 + (n >> 6)] >> (n & 63)) & 1ull) != 0ull; cs1 = ((selm[(qb + 4) * 2 + (n >> 6)] >> (n & 63)) & 1ull) != 0ull; }
            const bool act0 = ((VAR & 1) && slc) ? false : BALLOT(cs0) != 0ull, act1 = ((VAR & 1) && slc) ? false : BALLOT(cs1) != 0ull;
            if (near) {
                const int dmax = slc ? (1 << 30) : WIN - 1;
#pragma unroll
                for (int cg = 0; cg < 2; ++cg) { if (!(cg ? act1 : act0)) continue; f32x4 s[4]; bf16x8 pb[2]; const bool cs = cg ? cs1 : cs0; const float base = m[cg] <= -5e29f ? 0.f : m[cg];
                    { bf16x8 kf[8]; ld_frags(kf, kimg, fr, fq); qk2(kf, qf[cg], s, 0.f); }
                    bias_mask(s, btab, cs ? tq[cg] - 64 * n : -(1 << 29), 1, dmax, h, fq); sub_all(s, base);
                    softmax_lazy(s, m[cg], base, lacc[cg], o[cg], cs, pb);
                    { bf16x8 vf[8]; ld_frags(vf, vimg, fr, fq); pv2l(vf, pb, o[cg], lacc[cg], ones); } }
            } else if (act0 && act1) {
                f32x4 s0[4], s1[4]; bf16x8 pb0[2], pb1[2];
                const float base0 = m[0] <= -5e29f ? 0.f : m[0], base1 = m[1] <= -5e29f ? 0.f : m[1];
                { bf16x8 kf[8]; ld_frags(kf, kimg, fr, fq); qk2(kf, qf[0], s0, cs0 ? bfar - base0 : NEGF); qk2(kf, qf[1], s1, cs1 ? bfar - base1 : NEGF); }
                bf16x8 vf[8]; ld_frags(vf, vimg, fr, fq);
                if (edge) { mask_only(s0, tq[0] - 64 * n, WIN - 1, fq); mask_only(s1, tq[1] - 64 * n, WIN - 1, fq); }
                softmax_lazy(s0, m[0], base0, lacc[0], o[0], cs0, pb0);
                softmax_lazy(s1, m[1], base1, lacc[1], o[1], cs1, pb1);
                pv2l(vf, pb0, o[0], lacc[0], ones); pv2l(vf, pb1, o[1], lacc[1], ones);
            } else if (act0 || act1) {
#pragma unroll
                for (int cg = 0; cg < 2; ++cg) { if (!(cg ? act1 : act0)) continue; f32x4 s[4]; bf16x8 pb[2]; const bool cs = cg ? cs1 : cs0; const float base = m[cg] <= -5e29f ? 0.f : m[cg];
                    { bf16x8 kf[8]; ld_frags(kf, kimg, fr, fq); qk2(kf, qf[cg], s, cs ? bfar - base : NEGF); }
                    bf16x8 vf[8]; ld_frags(vf, vimg, fr, fq);
                    softmax_lazy(s, m[cg], base, lacc[cg], o[cg], cs, pb);
                    pv2l(vf, pb, o[cg], lacc[cg], ones); }
            }
            if (j == j_win - 1) {
                drain = true;
#pragma unroll
                for (int cg = 0; cg < 2; ++cg) { int tq_ = tq[cg]; OPAQUE_I(tq_); const float sc = p.gates[((size_t)b * S + tq_) * 24 + 8 + h] / fmaxf(xsum32(xsum16(lacc[cg][0])), 1e-30f); m[cg] = NEGF; lacc[cg] = (f32x4){0.f, 0.f, 0.f, 0.f};
                    float* ap = p.attn_acc + ((size_t)b * S + tq_) * 512 + h * 64 + 4 * fq;
#pragma unroll
                    for (int dt = 0; dt < 4; ++dt) { *(f32x4*)(ap + 16 * dt) = *(const f32x4*)(ap + 16 * dt) + o[cg][dt] * sc; o[cg][dt] = (f32x4){0.f, 0.f, 0.f, 0.f}; } }
            }
        }
        if (j + 2 < njobs && !drain) { VM_WAIT2(); } else { VM_WAIT0(); }
        BLOCK_BARRIER();
    }
#undef STAGE_DMA
#pragma unroll
    for (int cg = 0; cg < 2; ++cg) { int tq_ = tq[cg]; OPAQUE_I(tq_); const size_t rowo = (size_t)b * S + tq_;
        const float sc = p.gates[rowo * 24 + 16 + h] / fmaxf(xsum32(xsum16(lacc[cg][0])), 1e-30f);
#pragma unroll
        for (int dt = 0; dt < 4; ++dt) { const int d0 = 16 * dt + 4 * fq; const f32x4 v = *(const f32x4*)(p.attn_acc + rowo * 512 + h * 64 + d0) + o[cg][dt] * sc;
            const u32x2 z = *(const u32x2*)(p.reg5[0] + rowo * 512 + h * 64 + d0);
            const float z0 = bf2f((bf16)(z[0] & 0xFFFFu)), z1 = bf2f((bf16)(z[0] >> 16)), z2 = bf2f((bf16)(z[1] & 0xFFFFu)), z3 = bf2f((bf16)(z[1] >> 16));
            u32x2 w; w[0] = cvtpk(v[0] * siluf(z0), v[1] * siluf(z1)); w[1] = cvtpk(v[2] * siluf(z2), v[3] * siluf(z3));
            *(u32x2*)(p.mixed + rowo * 1024 + h * 64 + d0) = w; } }
}
template <int VAR = 0> DEV void attn_phase(const Params& p, LDSQ unsigned char* lds, int rep = 0) {
    const int tid = TIDX;
    LDSQ float* btab = (LDSQ float*)(lds + A_BIAS);
    for (int i = tid; i < 129 * 8; i += NTH) btab[i] = p.bias_tab[i] * LOG2E;
    LDSQ int* misc = (LDSQ int*)(lds + A_MISC);
    constexpr int NQ = NB * NG;
    const int q0 = (XCC_ID() >> 1) % NQ;
    int qi = 0;
    for (;;) {
        SYNCTHREADS();
        if (tid == 0) { int u = NSEL, q = 0;
            while (qi < NQ) { q = (q0 + qi) % NQ; u = (int)FETCH_ADD_U32(p.ctr + 64 * (rep * NQ + q), 1u); if (u < NSEL) break; ++qi; }
            misc[0] = qi < NQ ? q : -1; misc[1] = NSEL - 1 - u; misc[2] = qi; }
        SYNCTHREADS();
        const int q = misc[0], blk = misc[1]; qi = misc[2]; if (q < 0) break;
        attn_unit<VAR>(p, lds, q, blk);
    }
}
#ifndef HOST_EMU

__device__ __forceinline__ unsigned pk2(float lo, float hi) { return (unsigned)f2bf(lo) | ((unsigned)f2bf(hi) << 16); }
__device__ __forceinline__ float wave_sum(float v) {
#pragma unroll
    for (int o = 1; o < 64; o <<= 1) v += __shfl_xor(v, o);
    return v;
}
template <int MODE> __device__ __forceinline__ void p0_transpose_item(const Params& p, const float* W, int K, int N, int NPp, bf16* WT, LAS float* scr, int item, int lane) {
    const int nblk = NPp / 32, kb = item / nblk, nb = item % nblk, k0 = 64 * kb, n0 = 32 * nb;
    const int nn = n0 + (lane & 31); const int sc = MODE == 1 ? src_col(nn) : nn;
#pragma unroll 8
    for (int i = 0; i < 32; ++i) { const int kk = 2 * i + (lane >> 5); float v = 0.f;
        if (sc >= 0) { v = W[(size_t)(k0 + kk) * N + sc]; if (MODE == 1) v *= p.norm_w[k0 + kk]; }
        scr[kk * 33 + (lane & 31)] = v; }
    asm volatile("s_waitcnt lgkmcnt(0)" ::: "memory");
    const int c = lane & 7;
#pragma unroll
    for (int j = 0; j < 4; ++j) { const int n = (lane >> 3) + 8 * j; const LAS float* s = scr + (8 * c) * 33 + n;
        u32x4 o; o.x = pk2(s[0 * 33], s[1 * 33]); o.y = pk2(s[2 * 33], s[3 * 33]); o.z = pk2(s[4 * 33], s[5 * 33]); o.w = pk2(s[6 * 33], s[7 * 33]);
        *(u32x4*)(WT + (size_t)(n0 + n) * K + k0 + 8 * c) = o; }
    asm volatile("s_waitcnt lgkmcnt(0)" ::: "memory");
}
__device__ __forceinline__ void p0_prologue(const Params& p, LAS unsigned char* lds) {
    const int tid = threadIdx.x, lane = tid & 63, wave = tid >> 6;
    LAS float* scr = (LAS float*)(lds + wave * 16384);
    const int gw = blockIdx.x * NWAVES + wave, NGW = gridDim.x * NWAVES;
    constexpr int I_IN = (DM / 64) * (NP / 32), I_OUT = (DM / 64) * (DM / 32), I_W1 = (2048 / 64) * (128 / 32), I_W2 = (128 / 64) * (64 / 32);
    constexpr int NITEMS = I_IN + I_OUT + 2 * I_W1 + 2 * I_W2;
    for (int it = gw; it < NITEMS; it += NGW) {
        int r = it;
        if (r < I_IN) { p0_transpose_item<1>(p, p.w_in, DM, INCOLS, NP, p.wt_in, scr, r, lane); continue; } r -= I_IN;
        if (r < I_OUT) { p0_transpose_item<0>(p, p.w_out, DM, DM, DM, p.wt_out, scr, r, lane); continue; } r -= I_OUT;
        if (r < I_W1) { p0_transpose_item<0>(p, p.w_ck1, 2048, 128, 128, p.w1t[0], scr, r, lane); continue; } r -= I_W1;
        if (r < I_W1) { p0_transpose_item<0>(p, p.w_cv1, 2048, 128, 128, p.w1t[1], scr, r, lane); continue; } r -= I_W1;
        if (r < I_W2) { p0_transpose_item<0>(p, p.w_ck2, 128, 64, 64, p.w2t[0], scr, r, lane); continue; } r -= I_W2;
        p0_transpose_item<0>(p, p.w_cv2, 128, 64, 64, p.w2t[1], scr, r, lane);
    }
    for (int task = (NGW - 1 - gw); task < 256; task += NGW) { const int w = task >> 7, h = task & 127;
        const float* w1 = w ? p.w_cv1 : p.w_ck1; const float* pe = w ? p.pe_v : p.pe_k; float a = 0.f;
        for (int jd = lane; jd < 2048; jd += 64) a += pe[jd] * w1[(size_t)jd * 128 + h];
        a = wave_sum(a); if (lane == 0) p.peb[w][h] = a; }
    if (blockIdx.x == gridDim.x - 1) for (int i = tid; i < 129 * 8; i += NTHREADS) prep_bias_body(p, i);
    for (int m = gw; m < ROWS; m += NGW) {
        const f32x4* xr = (const f32x4*)(p.x + (size_t)m * DM) + lane; f32x4 v[4]; float s = 0.f;
#pragma unroll
        for (int j = 0; j < 4; ++j) { v[j] = xr[64 * j]; s += (v[j].x * v[j].x + v[j].y * v[j].y) + (v[j].z * v[j].z + v[j].w * v[j].w); }
        s = wave_sum(s);
        u32x2* o8 = (u32x2*)(p.xb + (size_t)m * DM) + lane;
#pragma unroll
        for (int j = 0; j < 4; ++j) { u32x2 w; w.x = pk2(v[j].x, v[j].y); w.y = pk2(v[j].z, v[j].w); o8[64 * j] = w; }
        if (lane == 0) p.rstd[m] = 1.0f / sqrtf(s * (1.0f / DM) + 1e-6f);
    }
}
struct EpiProj {
    static constexpr bool PERM = true, AFTER_DRAIN = false;
    const float* rstd; bf16* q; bf16* kv0; bf16* r50; float* gates;
    __device__ __forceinline__ void operator()(const f32x4 (&acc)[2][2][4][2], const pg8::Unit& u, int wr, int wc, int fr, int fq) const {
#pragma unroll
        for (int ai = 0; ai < 2; ++ai)
#pragma unroll
            for (int m = 0; m < 4; ++m) {
                const int row = u.pm * 256 + ai * 128 + wr * 64 + m * 16 + fr; const float rs = rstd[row]; const int b = row / S, s = row % S;
#pragma unroll
                for (int bj = 0; bj < 2; ++bj) {
                    const int col0 = u.pn * 256 + bj * 128 + wc * 32 + 8 * fq;
                    f32x4 v0 = acc[ai][bj][m][0] * rs, v1 = acc[ai][bj][m][1] * rs;
                    if (col0 >= 3840) {
                        if (col0 < 3864) { float* gp = gates + ((size_t)b * S + s) * 24 + (col0 - 3840);
                            *(f32x4*)gp = (f32x4){sigmf(v0[0]), sigmf(v0[1]), sigmf(v0[2]), sigmf(v0[3])}; *(f32x4*)(gp + 4) = (f32x4){sigmf(v1[0]), sigmf(v1[1]), sigmf(v1[2]), sigmf(v1[3])}; }
                        continue; }
                    bf16* dst;
                    if (col0 < 512) { v0 = v0 * QSCALE; v1 = v1 * QSCALE; dst = q + (((size_t)b * NH + (col0 >> 6)) * S + s) * 64 + (col0 & 63); }
                    else if (col0 < 1280) { const int j = (col0 - 512) >> 7, g = ((col0 - 512) >> 6) & 1; dst = kv0 + (size_t)j * KVSZ + (((size_t)b * NG + g) * S + s) * 64 + (col0 & 63); }
                    else { const int r = (col0 - 1280) >> 9, c = (col0 - 1280) & 511; dst = r50 + (size_t)r * R5SZ + ((size_t)b * S + s) * 512 + c; }
                    u32x4 w; w.x = pg8::cvt_pk_bf16(v0[0], v0[1]); w.y = pg8::cvt_pk_bf16(v0[2], v0[3]); w.z = pg8::cvt_pk_bf16(v1[0], v1[1]); w.w = pg8::cvt_pk_bf16(v1[2], v1[3]);
                    *(u32x4*)dst = w;
                }
            }
    }
};
struct EpiOut {
    static constexpr bool PERM = false, AFTER_DRAIN = false;
    const float* x; float* out; float* rowss;
    __device__ __forceinline__ void operator()(const f32x4 (&acc)[2][2][4][2], const pg8::Unit& u, int wr, int wc, int fr, int fq) const {
#pragma unroll
        for (int ai = 0; ai < 2; ++ai)
#pragma unroll
            for (int m = 0; m < 4; ++m) {
                const int row = u.pm * 256 + ai * 128 + wr * 64 + m * 16 + fr; float ss = 0.f;
#pragma unroll
                for (int bj = 0; bj < 2; ++bj)
#pragma unroll
                    for (int n = 0; n < 2; ++n) { const size_t off = (size_t)row * DM + u.pn * 256 + bj * 128 + wc * 32 + 16 * n + 4 * fq;
                        const f32x4 y = *(const f32x4*)(x + off) + acc[ai][bj][m][n]; *(f32x4*)(out + off) = y; ss += (y[0] * y[0] + y[1] * y[1]) + (y[2] * y[2] + y[3] * y[3]); }
                ss += __shfl_xor(ss, 16); ss += __shfl_xor(ss, 32);
                if (fq == 0) rowss[(size_t)row * 16 + u.pn * 4 + wc] = ss;
            }
    }
};
__device__ __forceinline__ void p4_final_norm(const Params& p) {
    const int tid = opaque_tid(), lane = tid & 63, wave = tid >> 6; const int gw = blockIdx.x * NWAVES + wave, NGW = gridDim.x * NWAVES;
    f32x4 w4[4];
#pragma unroll
    for (int j = 0; j < 4; ++j) w4[j] = *((const f32x4*)p.fnw + lane + 64 * j);
    for (int m = gw; m < ROWS; m += NGW) {
        float s = lane < 16 ? p.rowss[(size_t)m * 16 + lane] : 0.f;
        s += __shfl_xor(s, 1); s += __shfl_xor(s, 2); s += __shfl_xor(s, 4); s += __shfl_xor(s, 8); s = __shfl(s, 0);
        const float r = 1.0f / sqrtf(s * (1.0f / DM) + 1e-6f);
        f32x4* yr = (f32x4*)(p.out + (size_t)m * DM) + lane;
#pragma unroll
        for (int j = 0; j < 4; ++j) yr[64 * j] = yr[64 * j] * r * w4[j];
    }
}

__global__ void __launch_bounds__(NTHREADS, 2) mega_fwd(Params p) {
    extern __shared__ __attribute__((aligned(16))) unsigned char lds_raw[];
    LAS unsigned char* lds = (LAS unsigned char*)lds_raw;
    volatile LAS unsigned* st = (volatile LAS unsigned*)(lds + LDS_BYTES - 64);
    if (threadIdx.x < 16) st[threadIdx.x] = 0u;
    __syncthreads();
    const XcdBarrier bar = xcd_barrier_post(p.bar, st);
    const long T = (long)gridDim.x * NTHREADS, t0 = (long)blockIdx.x * NTHREADS + threadIdx.x;
#define SWEEP(name, n) for (long g_ = t0; g_ < (long)(n); g_ += T) name##_body(p, g_)
    for (int rep = 0; rep < REP_P0; ++rep) { p0_prologue(p, lds); xcd_barrier(bar); }
    for (int rep = 0; rep < REP_P1; ++rep) {
        pg8::Gemm g{p.xb, p.wt_in, ROWS, NP, DM}; pg8::StaticOrder so; so.init(ROWS, NP, (int)gridDim.x, (int)blockIdx.x);
        EpiProj E{p.rstd, p.q, p.kv[0], p.reg5[0], p.gates};
        pg8::gemm_phase<EpiProj, pg8::StaticOrder, true, true>(lds, g, so, E);
        xcd_barrier(bar);
    }
    for (int rep = 0; rep < REP_P2; ++rep) { p2_phase(p, lds); xcd_barrier(bar); }
    if (PROBE_VAR) { attn_phase<PROBE_VAR>(p, lds, 1); xcd_barrier(bar); }
    for (int rep = 0; rep < REP_P3; ++rep) { attn_phase<0>(p, lds, rep == 0 ? 0 : 1); xcd_barrier(bar); }
    for (int rep = 0; rep < REP_P4; ++rep) {
        pg8::Gemm g{p.mixed, p.wt_out, ROWS, DM, DM}; pg8::StaticOrder so; so.init(ROWS, DM, (int)gridDim.x, (int)blockIdx.x);
        EpiOut E{p.x, p.out, p.rowss};
        pg8::gemm_phase<EpiOut, pg8::StaticOrder, true, true>(lds, g, so, E);
        if (rep + 1 < REP_P4) xcd_barrier(bar);
    }
    xcd_barrier(bar);
    p4_final_norm(p);
}

extern "C" void kernel_launch(void* const* d_in, const int* in_sizes, int n_in, void* d_out, int out_size, void* d_ws, size_t ws_size, hipStream_t stream) {
    static int grid = 0;
    if (grid == 0) {
        int dev = 0, cus = 0, per_cu = 0;
        if (hipGetDevice(&dev) != hipSuccess || hipDeviceGetAttribute(&cus, hipDeviceAttributeMultiprocessorCount, dev) != hipSuccess) { fprintf(stderr, "kernel_launch: device query failed\n"); grid = -1; return; }
        if (hipFuncSetAttribute((const void*)mega_fwd, hipFuncAttributeMaxDynamicSharedMemorySize, LDS_BYTES) != hipSuccess) { fprintf(stderr, "kernel_launch: hipFuncSetAttribute failed\n"); grid = -1; return; }
        if (hipOccupancyMaxActiveBlocksPerMultiprocessor(&per_cu, (const void*)mega_fwd, NTHREADS, LDS_BYTES) != hipSuccess || per_cu < 1) { fprintf(stderr, "kernel_launch: occupancy query says %d blocks per CU\n", per_cu); grid = -1; return; }
        (void)hipGetLastError();
        grid = cus;
    }
    if (grid < 0) return;
    Params p; memset(&p, 0, sizeof(p));
    const float** ins[13] = {&p.x, &p.norm_w, &p.w_in, &p.w_ck1, &p.w_ck2, &p.pe_k, &p.w_cv1, &p.w_cv2, &p.pe_v, &p.conv_w, &p.w_out, &p.rel_bias, &p.fnw};
    for (int i = 0; i < 13; ++i) *ins[i] = (const float*)d_in[i];
    p.out = (float*)d_out;
    const size_t need = carve(p, (char*)d_ws);
    if (need > ws_size) { fprintf(stderr, "workspace too small: need %zu have %zu\n", need, ws_size); return; }
    if (hipMemsetAsync(p.bar, 0, 16384, stream) != hipSuccess) { fprintf(stderr, "kernel_launch: memset failed\n"); return; }
    hipLaunchKernelGGL(mega_fwd, dim3(grid), dim3(NTHREADS), LDS_BYTES, stream, p);
}
#endif
```
